# Optimizing an MI355X kernel written in HIP

```python
import math
import jax, jax.numpy as jnp
from jax import lax
import numpy as np

D_MODEL = 1024
BATCH = 8
SEQ = 2048
DEPTH = 1

SSM_WIDTH = D_MODEL // 2
SSM_GROUP = 16
SSM_GROUPS = SSM_WIDTH // SSM_GROUP
SSM_STATE = 64
ATTN_HEADS = 8
ATTN_HEAD_DIM = 64
ATTN_WIDTH = ATTN_HEADS * ATTN_HEAD_DIM
Q_BLOCK = 128
LN_EPS = 1e-5
DEEPNORM_ALPHA = (2.0 * DEPTH) ** 0.25
DEEPNORM_BETA = (8.0 * DEPTH) ** -0.25
IN_SPLITS = (SSM_WIDTH, SSM_WIDTH, ATTN_WIDTH, ATTN_WIDTH, ATTN_WIDTH, ATTN_HEADS,
             ATTN_WIDTH, D_MODEL, D_MODEL)
IN_COLS = sum(IN_SPLITS)

kernel_name = "hybrid_s5_fox_gated_deepnorm"


def _layer_norm(x, g=None, b=None):
    xf = x.astype(jnp.float32)
    mu = jnp.mean(xf, axis=-1, keepdims=True)
    var = jnp.mean(jnp.square(xf - mu), axis=-1, keepdims=True)
    y = (xf - mu) * lax.rsqrt(var + LN_EPS)
    if g is not None:
        y = y * g.astype(jnp.float32) + b.astype(jnp.float32)
    return y


def _complex_linear_op(e1, e2):
    a1r, a1i, b1r, b1i = e1
    a2r, a2i, b2r, b2i = e2
    return (a2r * a1r - a2i * a1i,
            a2r * a1i + a2i * a1r,
            a2r * b1r - a2i * b1i + b2r,
            a2r * b1i + a2i * b1r + b2i)


def _s5_mixer(u, lam_re, lam_im, log_dt, b_re, b_im, c_re, c_im, d_skip, w_glu):
    bsz, s_len, _ = u.shape
    uf = u.astype(jnp.float32).reshape(bsz, s_len, SSM_GROUPS, SSM_GROUP)
    lr = lam_re.astype(jnp.float32)
    li = lam_im.astype(jnp.float32)
    dt = jnp.exp(log_dt.astype(jnp.float32))[:, None]
    mag = jnp.exp(lr * dt)
    abr = mag * jnp.cos(li * dt)
    abi = mag * jnp.sin(li * dt)
    den = lr * lr + li * li
    cr = ((abr - 1.0) * lr + abi * li) / den
    ci = (abi * lr - (abr - 1.0) * li) / den
    br = b_re.astype(jnp.float32)
    bi = b_im.astype(jnp.float32)
    bbr = cr[..., None] * br - ci[..., None] * bi
    bbi = cr[..., None] * bi + ci[..., None] * br
    bu_r = jnp.einsum('bsgh,gph->bsgp', uf, bbr)
    bu_i = jnp.einsum('bsgh,gph->bsgp', uf, bbi)
    a_r = jnp.broadcast_to(abr[None, None], (1, s_len, SSM_GROUPS, SSM_STATE))
    a_i = jnp.broadcast_to(abi[None, None], (1, s_len, SSM_GROUPS, SSM_STATE))
    _, _, h_r, h_i = lax.associative_scan(_complex_linear_op, (a_r, a_i, bu_r, bu_i), axis=1)
    y = (jnp.einsum('bsgp,ghp->bsgh', h_r, c_re.astype(jnp.float32))
         - jnp.einsum('bsgp,ghp->bsgh', h_i, c_im.astype(jnp.float32))
         + d_skip.astype(jnp.float32).reshape(SSM_GROUPS, SSM_GROUP) * uf)
    y = jax.nn.gelu(y.reshape(bsz, s_len, SSM_WIDTH))
    glu_a, glu_b = jnp.split(y @ w_glu.astype(jnp.float32), 2, axis=-1)
    return glu_a * jax.nn.sigmoid(glu_b)


def _forgetting_attention(q, k, v, log_f):
    s_len = q.shape[2]
    cum_f = jnp.cumsum(log_f, axis=-1)
    scale = ATTN_HEAD_DIM ** -0.5
    outs = []
    for blk in range(s_len // Q_BLOCK):
        q0 = blk * Q_BLOCK
        end = q0 + Q_BLOCK
        qb = q[:, :, q0:end]
        kb = k[:, :, :end]
        vb = v[:, :, :end]
        logits = (jnp.einsum('bhqd,bhkd->bhqk', qb, kb) * scale
                  + cum_f[:, :, q0:end, None] - cum_f[:, :, None, :end])
        causal = jnp.arange(end)[None, :] <= jnp.arange(q0, end)[:, None]
        logits = jnp.where(causal, logits, -jnp.inf)
        p = jax.nn.softmax(logits, axis=-1)
        outs.append(jnp.einsum('bhqk,bhkd->bhqd', p, vb))
    return jnp.concatenate(outs, axis=2)


def setup_inputs(seed: int = 0) -> dict:
    key = jax.random.key(seed)
    ks = jax.random.split(key, 20)
    f32 = jnp.float32
    L = DEPTH
    x = jax.random.normal(ks[0], (BATCH, SEQ, D_MODEL), f32)
    c = jax.random.normal(ks[1], (BATCH, D_MODEL), f32)
    w_ada = jax.random.normal(ks[2], (L, D_MODEL, 3 * D_MODEL), f32) * (0.3 * D_MODEL ** -0.5)
    b_ada = jax.random.normal(ks[3], (L, 3 * D_MODEL), f32) * 0.01
    w_in = jax.random.normal(ks[4], (L, D_MODEL, IN_COLS), f32) * D_MODEL ** -0.5
    b_f = jax.random.uniform(ks[5], (L, ATTN_HEADS), f32, 1.0, 4.0)
    n_idx = jnp.arange(SSM_STATE, dtype=f32)
    lam_re = -0.5 + 0.01 * jax.random.normal(ks[6], (L, SSM_GROUPS, SSM_STATE), f32)
    lam_im = math.pi * n_idx + 0.01 * jax.random.normal(ks[7], (L, SSM_GROUPS, SSM_STATE), f32)
    log_dt = jax.random.uniform(ks[8], (L, SSM_GROUPS), f32, math.log(1e-3), math.log(1e-1))
    b_scale = (2.0 * SSM_GROUP) ** -0.5
    ssm_b_re = jax.random.normal(ks[9], (L, SSM_GROUPS, SSM_STATE, SSM_GROUP), f32) * b_scale
    ssm_b_im = jax.random.normal(ks[10], (L, SSM_GROUPS, SSM_STATE, SSM_GROUP), f32) * b_scale
    c_scale = SSM_STATE ** -0.5
    ssm_c_re = jax.random.normal(ks[11], (L, SSM_GROUPS, SSM_GROUP, SSM_STATE), f32) * c_scale
    ssm_c_im = jax.random.normal(ks[12], (L, SSM_GROUPS, SSM_GROUP, SSM_STATE), f32) * c_scale
    ssm_d = jax.random.normal(ks[13], (L, SSM_WIDTH), f32)
    w_glu = jax.random.normal(ks[14], (L, SSM_WIDTH, 2 * SSM_WIDTH), f32) * SSM_WIDTH ** -0.5
    w_proj_ssm = jax.random.normal(ks[15], (L, SSM_WIDTH, D_MODEL), f32) * (SSM_WIDTH ** -0.5 * DEEPNORM_BETA)
    w_proj_attn = jax.random.normal(ks[16], (L, ATTN_WIDTH, D_MODEL), f32) * (ATTN_WIDTH ** -0.5 * DEEPNORM_BETA)
    w_out = jax.random.normal(ks[17], (L, D_MODEL, D_MODEL), f32) * (D_MODEL ** -0.5 * DEEPNORM_BETA)
    ln_g = 1.0 + 0.01 * jax.random.normal(ks[18], (L, D_MODEL), f32)
    ln_b = 0.01 * jax.random.normal(ks[19], (L, D_MODEL), f32)
    return {"x": x, "c": c, "w_ada": w_ada, "b_ada": b_ada, "w_in": w_in, "b_f": b_f,
            "lam_re": lam_re, "lam_im": lam_im, "log_dt": log_dt,
            "ssm_b_re": ssm_b_re, "ssm_b_im": ssm_b_im, "ssm_c_re": ssm_c_re, "ssm_c_im": ssm_c_im,
            "ssm_d": ssm_d, "w_glu": w_glu, "w_proj_ssm": w_proj_ssm, "w_proj_attn": w_proj_attn,
            "w_out": w_out, "ln_g": ln_g, "ln_b": ln_b}


def reference(x, c, w_ada, b_ada, w_in, b_f, lam_re, lam_im, log_dt, ssm_b_re, ssm_b_im,
              ssm_c_re, ssm_c_im, ssm_d, w_glu, w_proj_ssm, w_proj_attn, w_out, ln_g, ln_b):
    bsz, s_len, _ = x.shape
    split_idx = [int(v) for v in np.cumsum(IN_SPLITS)[:-1]]
    c_act = jax.nn.silu(c.astype(jnp.float32))
    h = x.astype(jnp.float32)
    for l in range(DEPTH):
        mod = c_act @ w_ada[l].astype(jnp.float32) + b_ada[l].astype(jnp.float32)
        shift, scale, gate = jnp.split(mod, 3, axis=-1)
        u = _layer_norm(h) * (1.0 + scale[:, None, :]) + shift[:, None, :]
        proj = u @ w_in[l].astype(jnp.float32)
        (x_ssm, z_ssm, q, k, v, f_logit, z_attn, g_ssm, g_attn) = jnp.split(proj, split_idx, axis=-1)
        y_ssm = _s5_mixer(x_ssm, lam_re[l], lam_im[l], log_dt[l], ssm_b_re[l], ssm_b_im[l],
                          ssm_c_re[l], ssm_c_im[l], ssm_d[l], w_glu[l])
        y_ssm = (y_ssm * jax.nn.silu(z_ssm)) @ w_proj_ssm[l].astype(jnp.float32)
        to_heads = lambda t: t.reshape(bsz, s_len, ATTN_HEADS, ATTN_HEAD_DIM).transpose(0, 2, 1, 3)
        log_f = jax.nn.log_sigmoid(f_logit + b_f[l].astype(jnp.float32)).transpose(0, 2, 1)
        o = _forgetting_attention(to_heads(q), to_heads(k), to_heads(v), log_f)
        o = o.transpose(0, 2, 1, 3).reshape(bsz, s_len, ATTN_WIDTH)
        y_attn = (o * jax.nn.silu(z_attn)) @ w_proj_attn[l].astype(jnp.float32)
        merged = jax.nn.sigmoid(g_ssm) * y_ssm + jax.nn.sigmoid(g_attn) * y_attn
        sub = (merged @ w_out[l].astype(jnp.float32)) * gate[:, None, :]
        h = _layer_norm(DEEPNORM_ALPHA * h + sub, ln_g[l], ln_b[l])
    return h.astype(x.dtype)
```

```cpp
#include <hip/hip_runtime.h>
#include <stdio.h>
#include <stdint.h>

#define DI __device__ __forceinline__
typedef unsigned short u16;
using bf16x8 = __attribute__((ext_vector_type(8))) short;
using f32x16 = __attribute__((ext_vector_type(16))) float;
using f32x4  = __attribute__((ext_vector_type(4))) float;
using u32x4  = __attribute__((ext_vector_type(4))) unsigned;
using u32x2  = __attribute__((ext_vector_type(2))) unsigned;
typedef __bf16 bf16x2_t __attribute__((ext_vector_type(2)));
typedef float f32x2_t __attribute__((ext_vector_type(2)));

#define MFMA(a, b, c) __builtin_amdgcn_mfma_f32_32x32x16_bf16((a), (b), (c), 0, 0, 0)

DI unsigned pk2(float lo, float hi) { f32x2_t v = {lo, hi}; return __builtin_bit_cast(unsigned, __builtin_convertvector(v, bf16x2_t)); }
DI u16 f2bf(float x) { return (u16)(pk2(x, 0.f) & 0xffffu); }
DI float bf2f(unsigned h) { return __uint_as_float(h << 16); }
DI float bflo(unsigned w) { return __uint_as_float(w << 16); }
DI float bfhi(unsigned w) { return __uint_as_float(w & 0xffff0000u); }
DI float sigmoidf_(float x) { return 1.f / (1.f + __expf(-x)); }
DI float siluf_(float x) { return x / (1.f + __expf(-x)); }

constexpr int NTOK = 16384, SEQ = 2048, DM = 1024, INCOLS = 5128;
constexpr float LN_EPS = 1e-5f;
constexpr float DN_ALPHA = 1.189207115002721f;
constexpr float LOG2E = 1.4426950408889634f;

constexpr size_t OFF_BAR   = 0;
constexpr size_t OFF_MOD   = 16384;
constexpr size_t OFF_APL   = OFF_MOD + 98304;
constexpr size_t OFF_LOGF  = OFF_APL + 16384;
constexpr size_t OFF_CUMF  = OFF_LOGF + 524288;
constexpr size_t OFF_KUNIQ = OFF_CUMF + 524288;
constexpr size_t OFF_WST   = OFF_KUNIQ + 1048576;
constexpr size_t OFF_WCT   = OFF_WST + 8388608;
constexpr size_t OFF_HIN   = OFF_WCT + 8388608;
constexpr size_t OFF_WINT  = OFF_HIN + 2097152;
constexpr size_t OFF_WGLUT = OFF_WINT + 10485760;
constexpr size_t OFF_WPST  = OFF_WGLUT + 1048576;
constexpr size_t OFF_WPAT  = OFF_WPST + 1048576;
constexpr size_t OFF_WOUTT = OFF_WPAT + 1048576;
constexpr size_t OFF_U     = OFF_WOUTT + 2097152;
constexpr size_t OFF_XS    = OFF_U + 33554432;
constexpr size_t OFF_ZS    = OFF_XS + 16777216;
constexpr size_t OFF_Q     = OFF_ZS + 16777216;
constexpr size_t OFF_K     = OFF_Q + 16777216;
constexpr size_t OFF_VT    = OFF_K + 16777216;
constexpr size_t OFF_ZA    = OFF_VT + 16777216;
constexpr size_t OFF_GS    = OFF_ZA + 16777216;
constexpr size_t OFF_GA    = OFF_GS + 33554432;
constexpr size_t WS_END    = OFF_GA + 33554432;

struct Params {
    const float *x, *c, *w_ada, *b_ada, *w_in, *b_f, *lam_re, *lam_im, *log_dt, *b_re, *b_im, *c_re, *c_im, *ssm_d,
                *w_glu, *w_ps, *w_pa, *w_out, *ln_g, *ln_b;
    float* out;
    unsigned char* ws;
};

#define XB_TMO      128
#define XB_XCNT(j)  (256  + 64 * (j))
#define XB_XSUB(j)  (1280 + 64 * (j))
#define XB_XGEN(j)  (2304 + 64 * (j))
#define XB_TOP      3328
#define XB_TOPGEN   3392
#define XCD_BAR_WORDS 3456
#define XB_SPIN_CAP (1u << 22)

DI unsigned xb_ld(unsigned* p)              { return __hip_atomic_load(p, __ATOMIC_RELAXED, __HIP_MEMORY_SCOPE_AGENT); }
DI unsigned xb_add(unsigned* p, unsigned v) { return __hip_atomic_fetch_add(p, v, __ATOMIC_RELAXED, __HIP_MEMORY_SCOPE_AGENT); }
DI unsigned xb_xcc_id() { return (unsigned)__builtin_amdgcn_s_getreg((3 << 11) | 20) & 0xFu; }
#define XB_SPIN(cond, bar) do { unsigned _sp = 0; while (cond) { __builtin_amdgcn_s_sleep(1); \
    if ((++_sp & 255u) == 0u) { if (xb_ld(&(bar)[XB_TMO])) break; if (_sp > XB_SPIN_CAP) { atomicAdd(&(bar)[XB_TMO], 1u); break; } } } } while (0)

struct XcdBarrier { unsigned* bar; unsigned x; volatile unsigned* st; };

DI void xcd_barrier_complete(unsigned* bar, unsigned x, unsigned& nloc, unsigned& nx) {
    const unsigned G = gridDim.x;
    unsigned sum, cnt, mine, sp = 0u;
    for (;;) {
        sum = 0u; cnt = 0u; mine = 0u;
#pragma unroll
        for (unsigned j = 0; j < 16; ++j) { const unsigned c = xb_ld(&bar[XB_XCNT(j)]); sum += c; cnt += (c > 0u) ? 1u : 0u; mine = (j == x) ? c : mine; }
        if (sum == G) break;
        __builtin_amdgcn_s_sleep(1);
        if ((++sp & 255u) == 0u) { if (xb_ld(&bar[XB_TMO])) break; if (sp > XB_SPIN_CAP) { atomicAdd(&bar[XB_TMO], 1u); break; } }
    }
    nloc = mine > 0u ? mine : 1u; nx = cnt > 0u ? cnt : 1u;
}

DI void xcd_barrier(const XcdBarrier& b) {
    asm volatile("s_waitcnt vmcnt(0)" ::: "memory");
    __syncthreads();
    if (threadIdx.x == 0) {
        unsigned* bar = b.bar;
        __builtin_amdgcn_s_waitcnt(0);
        unsigned nloc = b.st[0], nx = b.st[1];
        if (nloc == 0u) { xcd_barrier_complete(bar, b.x, nloc, nx); b.st[0] = nloc; b.st[1] = nx; }
        const unsigned old = xb_add(&bar[XB_XSUB(b.x)], 1u);
        const unsigned gen = old / nloc;
        if (old + 1u == (gen + 1u) * nloc) {
            __builtin_amdgcn_fence(__ATOMIC_RELEASE, "agent");
            asm volatile("s_waitcnt vmcnt(0)" ::: "memory");
            const unsigned og = xb_add(&bar[XB_TOP], 1u);
            const unsigned tg = og / nx;
            if (og + 1u == (tg + 1u) * nx) xb_add(&bar[XB_TOPGEN], 1u);
            else XB_SPIN(xb_ld(&bar[XB_TOPGEN]) == tg, bar);
            __builtin_amdgcn_fence(__ATOMIC_ACQUIRE, "agent");
            xb_add(&bar[XB_XGEN(b.x)], 1u);
            asm volatile("s_waitcnt vmcnt(0)" ::: "memory");
        } else {
            XB_SPIN(xb_ld(&bar[XB_XGEN(b.x)]) == gen, bar);
            __builtin_amdgcn_fence(__ATOMIC_ACQUIRE, "agent");
            asm volatile("s_waitcnt vmcnt(0)" ::: "memory");
        }
    }
    __syncthreads();
}

DI float wave_sum(float v) {
#pragma unroll
    for (int o = 32; o > 0; o >>= 1) v += __shfl_xor(v, o, 64);
    return v;
}
DI u32x4 ldg16(const u16* p) { return *(const u32x4*)p; }
DI u32x4 zero4() { u32x4 z = {0u, 0u, 0u, 0u}; return z; }

constexpr int LDT = 72;
template <int MT, class FA, class FB>
DI void gemm_mainloop(f32x16 (&acc)[MT][2], int nk, FA fa, FB fb, u16* sA, u16* sB) {
    const int tid = threadIdx.x, lane = tid & 63, w = tid >> 6, wr = w >> 1, wc = w & 1;
    const int cch = tid & 7, r0 = tid >> 3;
    u32x4 ra[MT * 2], rb[4];
#pragma unroll
    for (int i = 0; i < MT * 2; ++i) ra[i] = fa(r0 + 32 * i, 0, cch);
#pragma unroll
    for (int i = 0; i < 4; ++i) rb[i] = fb(r0 + 32 * i, 0, cch);
    for (int ks = 0; ks < nk; ++ks) {
        __syncthreads();
#pragma unroll
        for (int i = 0; i < MT * 2; ++i) *(u32x4*)&sA[(r0 + 32 * i) * LDT + cch * 8] = ra[i];
#pragma unroll
        for (int i = 0; i < 4; ++i) *(u32x4*)&sB[(r0 + 32 * i) * LDT + cch * 8] = rb[i];
        __syncthreads();
        if (ks + 1 < nk) {
#pragma unroll
            for (int i = 0; i < MT * 2; ++i) ra[i] = fa(r0 + 32 * i, ks + 1, cch);
#pragma unroll
            for (int i = 0; i < 4; ++i) rb[i] = fb(r0 + 32 * i, ks + 1, cch);
        }
#pragma unroll
        for (int kk = 0; kk < 4; ++kk) {
            bf16x8 af[MT], bfr[2];
#pragma unroll
            for (int mi = 0; mi < MT; ++mi) af[mi] = *(const bf16x8*)&sA[(wr * 32 * MT + mi * 32 + (lane & 31)) * LDT + kk * 16 + (lane >> 5) * 8];
#pragma unroll
            for (int ni = 0; ni < 2; ++ni) bfr[ni] = *(const bf16x8*)&sB[(wc * 64 + ni * 32 + (lane & 31)) * LDT + kk * 16 + (lane >> 5) * 8];
#pragma unroll
            for (int mi = 0; mi < MT; ++mi)
#pragma unroll
                for (int ni = 0; ni < 2; ++ni) acc[mi][ni] = MFMA(af[mi], bfr[ni], acc[mi][ni]);
        }
    }
}
template <int MT>
DI void zero_acc(f32x16 (&acc)[MT][2]) {
#pragma unroll
    for (int mi = 0; mi < MT; ++mi)
#pragma unroll
        for (int ni = 0; ni < 2; ++ni)
#pragma unroll
            for (int i = 0; i < 16; ++i) acc[mi][ni][i] = 0.f;
}

DI void pa_mod(const Params& P, int item, float* smem) {
    const int tid = threadIdx.x;
    float* sc = smem;
    float* red = smem + 8192;
    __syncthreads();
    for (int i = tid; i < 8192; i += 256) { const int b = i >> 10, k = i & 1023; sc[k * 8 + b] = siluf_(P.c[i]); }
    __syncthreads();
    const int nl = tid & 31, ks = tid >> 5, n = item * 32 + nl;
    float acc[8];
#pragma unroll
    for (int b = 0; b < 8; ++b) acc[b] = 0.f;
    for (int k = ks * 128; k < ks * 128 + 128; ++k) {
        const float wv = P.w_ada[(size_t)k * 3072 + n];
        const f32x4 s0 = *(const f32x4*)&sc[k * 8], s1 = *(const f32x4*)&sc[k * 8 + 4];
        acc[0] += s0[0] * wv; acc[1] += s0[1] * wv; acc[2] += s0[2] * wv; acc[3] += s0[3] * wv;
        acc[4] += s1[0] * wv; acc[5] += s1[1] * wv; acc[6] += s1[2] * wv; acc[7] += s1[3] * wv;
    }
#pragma unroll
    for (int b = 0; b < 8; ++b) red[(ks * 8 + b) * 32 + nl] = acc[b];
    __syncthreads();
    {
        const int b = tid >> 5;
        float s = P.b_ada[n];
#pragma unroll
        for (int k2 = 0; k2 < 8; ++k2) s += red[(k2 * 8 + b) * 32 + nl];
        ((float*)(P.ws + OFF_MOD))[b * 3072 + n] = s;
    }
}

DI int srccol(int mode, int n) {
    if (mode == 0) return n + (n >= 2560 ? 8 : 0);
    if (mode == 1) { const int ni = (n >> 5) & 1, wc = (n >> 6) & 1, nt = n >> 7, j = n & 31; return ni * 512 + nt * 64 + wc * 32 + j; }
    return n;
}
DI void pa_transpose(const float* src, int ld, int K, u16* dst, int mode, int kt, int nt, u16* sT) {
    const int tid = threadIdx.x;
    __syncthreads();
    const int nl = tid & 63, kq = tid >> 6;
    const int sc = srccol(mode, nt * 64 + nl);
#pragma unroll
    for (int r = 0; r < 16; ++r) {
        const int k = r * 4 + kq;
        sT[k * 66 + nl] = f2bf(src[(size_t)(kt * 64 + k) * ld + sc]);
    }
    __syncthreads();
    const int n = tid >> 2, kc = (tid & 3) * 16;
    unsigned v[8];
#pragma unroll
    for (int j = 0; j < 8; ++j) v[j] = (unsigned)sT[(kc + 2 * j) * 66 + n] | ((unsigned)sT[(kc + 2 * j + 1) * 66 + n] << 16);
    u16* d = dst + (size_t)(nt * 64 + n) * K + kt * 64 + kc;
    u32x4 o0 = {v[0], v[1], v[2], v[3]}, o1 = {v[4], v[5], v[6], v[7]};
    *(u32x4*)d = o0; *(u32x4*)(d + 8) = o1;
}

DI void pa_s5(const Params& P, int g, int j, float* smem) {
    const int tid = threadIdx.x;
    f32x2_t* sAp = (f32x2_t*)smem;
    f32x2_t* sBb = sAp + 64 * 9;
    f32x2_t* sC  = sBb + 64 * 16;
    f32x2_t* sCo = sC + 16 * 64;
    __syncthreads();
    const float dt = expf(P.log_dt[g]);
    if (tid < 64) {
        const float lr = P.lam_re[g * 64 + tid], li = P.lam_im[g * 64 + tid];
        const float th = li * dt, lm = lr * dt;
        double a = (double)th; a -= 6.283185307179586 * __builtin_rint(a * 0.15915494309189535);
        const float rr = (float)a, mag = expf(lm);
        const float abr = mag * cosf(rr), abi = mag * sinf(rr);
        const float den = lr * lr + li * li;
        f32x2_t co; co[0] = ((abr - 1.f) * lr + abi * li) / den; co[1] = (abi * lr - (abr - 1.f) * li) / den;
        sCo[tid] = co;
    }
    for (int i = tid; i < 576; i += 256) {
        const int p = i / 9, el = i % 9, e = 8 * j + el;
        const float lr = P.lam_re[g * 64 + p], li = P.lam_im[g * 64 + p];
        const float th = li * dt, lm = lr * dt;
        double a = (double)e * (double)th; a -= 6.283185307179586 * __builtin_rint(a * 0.15915494309189535);
        const float rr = (float)a, mag = expf((float)e * lm);
        f32x2_t v; v[0] = mag * cosf(rr); v[1] = mag * sinf(rr);
        sAp[p * 9 + el] = v;
    }
    __syncthreads();
    for (int i = tid; i < 1024; i += 256) {
        const int p = i >> 4, hi = i & 15;
        const float br = P.b_re[(g * 64 + p) * 16 + hi], bi = P.b_im[(g * 64 + p) * 16 + hi];
        const f32x2_t co = sCo[p];
        f32x2_t v; v[0] = co[0] * br - co[1] * bi; v[1] = co[0] * bi + co[1] * br;
        sBb[p * 16 + hi] = v;
        const int ho = i >> 6, p2 = i & 63;
        f32x2_t cv; cv[0] = P.c_re[(g * 16 + ho) * 64 + p2]; cv[1] = P.c_im[(g * 16 + ho) * 64 + p2];
        sC[ho * 64 + p2] = cv;
    }
    __syncthreads();
    {
        const int ho = tid >> 4, hi = tid & 15;
        float acc[8];
#pragma unroll
        for (int l = 0; l < 8; ++l) acc[l] = 0.f;
        for (int p = 0; p < 64; ++p) {
            const f32x2_t cv = sC[ho * 64 + p], bb = sBb[p * 16 + hi];
            const float cbr = cv[0] * bb[0] - cv[1] * bb[1], cbi = cv[0] * bb[1] + cv[1] * bb[0];
#pragma unroll
            for (int l = 0; l < 8; ++l) { const f32x2_t ap = sAp[p * 9 + l]; acc[l] += cbr * ap[0] - cbi * ap[1]; }
        }
        if (j == 0 && ho == hi) acc[0] += P.ssm_d[g * 16 + ho];
        u16* ku = (u16*)(P.ws + OFF_KUNIQ);
#pragma unroll
        for (int l = 0; l < 8; ++l) ku[((g * 64 + 8 * j + l) * 16 + ho) * 16 + hi] = f2bf(acc[l]);
    }
    {
        u16* wst = (u16*)(P.ws + OFF_WST);
        for (int idx = tid; idx < 16384; idx += 256) {
            const int hi = idx & 15, sl = (idx >> 4) & 7, n = idx >> 7, p = n >> 1, ri = n & 1;
            const f32x2_t ap = sAp[p * 9 + (7 - sl)], bb = sBb[p * 16 + hi];
            const float v = ri ? (ap[0] * bb[1] + ap[1] * bb[0]) : (ap[0] * bb[0] - ap[1] * bb[1]);
            wst[(size_t)(g * 128 + n) * 1024 + (56 - 8 * j + sl) * 16 + hi] = f2bf(v);
        }
    }
    {
        u16* wct = (u16*)(P.ws + OFF_WCT);
        for (int idx = tid; idx < 16384; idx += 256) {
            const int k = idx & 127, ho = (idx >> 7) & 15, tl = idx >> 11, p = k >> 1, ri = k & 1;
            const f32x2_t ap = sAp[p * 9 + tl + 1], cv = sC[ho * 64 + p];
            const float v = ri ? -(cv[0] * ap[1] + cv[1] * ap[0]) : (cv[0] * ap[0] - cv[1] * ap[1]);
            wct[(size_t)(g * 1024 + (8 * j + tl) * 16 + ho) * 128 + k] = f2bf(v);
        }
    }
    if (j == 7 && tid < 64) ((f32x2_t*)(P.ws + OFF_APL))[g * 64 + tid] = sAp[tid * 9 + 8];
}

DI void pa2_rows(const Params& P, int item, const float* sWf) {
    const int tid = threadIdx.x, lane = tid & 63, w = tid >> 6;
    const int row0 = item * 32 + w * 8, b = row0 >> 11;
    const float* mod = (const float*)(P.ws + OFF_MOD) + b * 3072;
    f32x4 sh[4], sc[4];
#pragma unroll
    for (int c = 0; c < 4; ++c) {
        sh[c] = *(const f32x4*)&mod[c * 256 + lane * 4];
        sc[c] = *(const f32x4*)&mod[1024 + c * 256 + lane * 4];
    }
    u16* U = (u16*)(P.ws + OFF_U);
    float* logf = (float*)(P.ws + OFF_LOGF);
    for (int r = 0; r < 8; ++r) {
        const int row = row0 + r;
        f32x4 xv[4];
#pragma unroll
        for (int c = 0; c < 4; ++c) xv[c] = *(const f32x4*)&P.x[(size_t)row * 1024 + c * 256 + lane * 4];
        float s = 0.f;
#pragma unroll
        for (int c = 0; c < 4; ++c) s += (xv[c][0] + xv[c][1]) + (xv[c][2] + xv[c][3]);
        const float mu = wave_sum(s) * (1.f / 1024.f);
        float v = 0.f;
#pragma unroll
        for (int c = 0; c < 4; ++c)
#pragma unroll
            for (int i = 0; i < 4; ++i) { const float d = xv[c][i] - mu; v += d * d; }
        const float rstd = 1.f / sqrtf(wave_sum(v) * (1.f / 1024.f) + LN_EPS);
        float part[8];
#pragma unroll
        for (int h = 0; h < 8; ++h) part[h] = 0.f;
#pragma unroll
        for (int c = 0; c < 4; ++c) {
            f32x4 u;
#pragma unroll
            for (int i = 0; i < 4; ++i) u[i] = (xv[c][i] - mu) * rstd * (1.f + sc[c][i]) + sh[c][i];
            u32x2 o; o[0] = pk2(u[0], u[1]); o[1] = pk2(u[2], u[3]);
            *(u32x2*)&U[(size_t)row * 1024 + c * 256 + lane * 4] = o;
#pragma unroll
            for (int h = 0; h < 8; ++h) {
                const f32x4 wv = *(const f32x4*)&sWf[h * 1024 + c * 256 + lane * 4];
                part[h] += u[0] * wv[0] + u[1] * wv[1] + u[2] * wv[2] + u[3] * wv[3];
            }
        }
#pragma unroll
        for (int h = 0; h < 8; ++h) part[h] = wave_sum(part[h]);
        if (lane < 8) {
            float f = part[0];
#pragma unroll
            for (int h = 1; h < 8; ++h) f = (lane == h) ? part[h] : f;
            const float z = f + P.b_f[lane];
            const float lf = fminf(z, 0.f) - log1pf(expf(-fabsf(z)));
            logf[(size_t)(b * 8 + lane) * 2048 + (row & 2047)] = lf;
        }
    }
}

DI void pb_cumsum(const Params& P, int seq, float* smem) {
    const int tid = threadIdx.x;
    const float* lf = (const float*)(P.ws + OFF_LOGF) + (size_t)seq * 2048;
    float* cf = (float*)(P.ws + OFF_CUMF) + (size_t)seq * 2048;
    __syncthreads();
    f32x4 a = *(const f32x4*)&lf[tid * 8], b4 = *(const f32x4*)&lf[tid * 8 + 4];
    float v[8] = {a[0], a[1], a[2], a[3], b4[0], b4[1], b4[2], b4[3]};
#pragma unroll
    for (int i = 1; i < 8; ++i) v[i] += v[i - 1];
    smem[tid] = v[7];
    __syncthreads();
    if (tid == 0) { float run = 0.f; for (int i = 0; i < 256; ++i) { const float t = smem[i]; smem[i] = run; run += t; } }
    __syncthreads();
    const float off = smem[tid];
    f32x4 o0 = {v[0] + off, v[1] + off, v[2] + off, v[3] + off}, o1 = {v[4] + off, v[5] + off, v[6] + off, v[7] + off};
    *(f32x4*)&cf[tid * 8] = o0; *(f32x4*)&cf[tid * 8 + 4] = o1;
}

DI void pb_gemm1(const Params& P, int mt, int nt, u16* smem) {
    const u16* U = (const u16*)(P.ws + OFF_U);
    const u16* W = (const u16*)(P.ws + OFF_WINT);
    f32x16 acc[2][2];
    zero_acc<2>(acc);
    const u16* Ab = U + (size_t)mt * 128 * 1024;
    const u16* Bb = W + (size_t)nt * 128 * 1024;
    gemm_mainloop<2>(acc, 16,
        [=](int r, int ks, int c) { return ldg16(Ab + (size_t)r * 1024 + ks * 64 + c * 8); },
        [=](int r, int ks, int c) { return ldg16(Bb + (size_t)r * 1024 + ks * 64 + c * 8); },
        smem, smem + 128 * LDT);
    const int lane = threadIdx.x & 63, w = threadIdx.x >> 6, wr = w >> 1, wc = w & 1, hf = lane >> 5;
    const int seg = nt >> 2;
    if (seg == 4) {
        u16* VT = (u16*)(P.ws + OFF_VT);
#pragma unroll
        for (int mi = 0; mi < 2; ++mi)
#pragma unroll
            for (int ni = 0; ni < 2; ++ni) {
                const int nseg = (nt & 3) * 128 + wc * 64 + ni * 32 + (lane & 31), h = nseg >> 6, d = nseg & 63;
#pragma unroll
                for (int q = 0; q < 4; ++q) {
                    const int tok = mt * 128 + wr * 64 + mi * 32 + 8 * q + 4 * hf, b = tok >> 11, t = tok & 2047;
                    u32x2 o; o[0] = pk2(acc[mi][ni][4 * q], acc[mi][ni][4 * q + 1]); o[1] = pk2(acc[mi][ni][4 * q + 2], acc[mi][ni][4 * q + 3]);
                    *(u32x2*)&VT[((size_t)(b * 8 + h) * 64 + d) * 2048 + t] = o;
                }
            }
        return;
    }
    u16* dst; int ld, colbase, act;
    if (seg <= 5) {
        dst = (u16*)(P.ws + (seg == 0 ? OFF_XS : seg == 1 ? OFF_ZS : seg == 2 ? OFF_Q : seg == 3 ? OFF_K : OFF_ZA));
        ld = 512; colbase = (nt & 3) * 128; act = (seg == 1 || seg == 5) ? 1 : 0;
    } else if (seg <= 7) { dst = (u16*)(P.ws + OFF_GS); ld = 1024; colbase = (nt - 24) * 128; act = 2; }
    else { dst = (u16*)(P.ws + OFF_GA); ld = 1024; colbase = (nt - 32) * 128; act = 2; }
#pragma unroll
    for (int mi = 0; mi < 2; ++mi)
#pragma unroll
        for (int ni = 0; ni < 2; ++ni) {
            const int col = colbase + wc * 64 + ni * 32 + (lane & 31);
#pragma unroll
            for (int i = 0; i < 16; ++i) {
                const int row = mt * 128 + wr * 64 + mi * 32 + (i & 3) + 8 * (i >> 2) + 4 * hf;
                float v = acc[mi][ni][i];
                if (act == 1) v = siluf_(v); else if (act == 2) v = sigmoidf_(v);
                dst[(size_t)row * ld + col] = f2bf(v);
            }
        }
}

DI void pc_s5a(const Params& P, int g, int mq, u16* smem) {
    const int tid = threadIdx.x;
    const u16* XS = (const u16*)(P.ws + OFF_XS);
    const u16* WST = (const u16*)(P.ws + OFF_WST) + (size_t)g * 128 * 1024;
    f32x16 acc[1][2];
    zero_acc<1>(acc);
    const int m0 = mq * 64;
    gemm_mainloop<1>(acc, 16,
        [=](int r, int ks, int c) { const int m = m0 + r, tok = (m >> 5) * 2048 + (m & 31) * 64 + ks * 4 + (c >> 1);
                                    return ldg16(XS + (size_t)tok * 512 + g * 16 + (c & 1) * 8); },
        [=](int r, int ks, int c) { return ldg16(WST + (size_t)r * 1024 + ks * 64 + c * 8); },
        smem, smem + 128 * LDT);
    __syncthreads();
    float* sH = (float*)smem;
    {
        const int lane = tid & 63, w = tid >> 6, wr = w >> 1, wc = w & 1, hf = lane >> 5;
#pragma unroll
        for (int ni = 0; ni < 2; ++ni)
#pragma unroll
            for (int i = 0; i < 16; ++i) {
                const int row = wr * 32 + (i & 3) + 8 * (i >> 2) + 4 * hf, col = wc * 64 + ni * 32 + (lane & 31);
                sH[row * 132 + col] = acc[0][ni][i];
            }
    }
    __syncthreads();
    if (tid < 128) {
        const int bb = tid >> 6, p = tid & 63;
        const f32x2_t al = ((const f32x2_t*)(P.ws + OFF_APL))[g * 64 + p];
        u16* HIN = (u16*)(P.ws + OFF_HIN);
        float hr = 0.f, hi = 0.f;
        for (int c = 0; c < 32; ++c) {
            const int m = m0 + bb * 32 + c;
            *(unsigned*)&HIN[(size_t)(g * 256 + m) * 128 + 2 * p] = pk2(hr, hi);
            const float er = sH[(bb * 32 + c) * 132 + 2 * p], ei = sH[(bb * 32 + c) * 132 + 2 * p + 1];
            const float nr = al[0] * hr - al[1] * hi + er, ni2 = al[0] * hi + al[1] * hr + ei;
            hr = nr; hi = ni2;
        }
    }
}

DI void pc_attn(const Params& P, int b, int h, int qt, u16* smem) {
    const int tid = threadIdx.x, lane = tid & 63, w = tid >> 6, hf = lane >> 5, l31 = lane & 31;
    u16* sK = smem;
    u16* sV = smem + 64 * LDT;
    float* sNb = (float*)(smem + 128 * LDT);
    const u16* Q = (const u16*)(P.ws + OFF_Q);
    const u16* K = (const u16*)(P.ws + OFF_K);
    const u16* VT = (const u16*)(P.ws + OFF_VT);
    const u16* ZA = (const u16*)(P.ws + OFF_ZA);
    const float* CF = (const float*)(P.ws + OFF_CUMF) + (size_t)(b * 8 + h) * 2048;
    const int qbase = qt * 128 + w * 32, qrow = qbase + l31;
    const size_t tokq = (size_t)b * 2048 + qrow;
    bf16x8 qf[4];
#pragma unroll
    for (int ds = 0; ds < 4; ++ds) qf[ds] = *(const bf16x8*)&Q[tokq * 512 + h * 64 + ds * 16 + hf * 8];
    f32x16 o[2];
#pragma unroll
    for (int i = 0; i < 16; ++i) { o[0][i] = 0.f; o[1][i] = 0.f; }
    float m = -INFINITY, lsum = 0.f;
    const int nkt = 2 * (qt + 1);
    const float c1 = 0.125f * LOG2E;
    const int cch = tid & 7, r0 = tid >> 3;
    const u16* Kb = K + ((size_t)b * 2048) * 512 + h * 64;
    const u16* Vb = VT + ((size_t)(b * 8 + h) * 64) * 2048;
    u32x4 rk[2], rv[2]; float rnb = 0.f;
#pragma unroll
    for (int i = 0; i < 2; ++i) { rk[i] = ldg16(Kb + (size_t)(r0 + 32 * i) * 512 + cch * 8); rv[i] = ldg16(Vb + (size_t)(r0 + 32 * i) * 2048 + cch * 8); }
    if (tid < 64) rnb = -CF[tid] * LOG2E;
    for (int kt = 0; kt < nkt; ++kt) {
        __syncthreads();
#pragma unroll
        for (int i = 0; i < 2; ++i) { *(u32x4*)&sK[(r0 + 32 * i) * LDT + cch * 8] = rk[i]; *(u32x4*)&sV[(r0 + 32 * i) * LDT + cch * 8] = rv[i]; }
        if (tid < 64) sNb[tid] = rnb;
        __syncthreads();
        if (kt + 1 < nkt) {
            const int k1 = (kt + 1) * 64;
#pragma unroll
            for (int i = 0; i < 2; ++i) { rk[i] = ldg16(Kb + (size_t)(k1 + r0 + 32 * i) * 512 + cch * 8); rv[i] = ldg16(Vb + (size_t)(r0 + 32 * i) * 2048 + k1 + cch * 8); }
            if (tid < 64) rnb = -CF[k1 + tid] * LOG2E;
        }
        const int k0 = kt * 64;
        if (k0 <= qbase + 31) {
            f32x16 s[2];
#pragma unroll
            for (int kb = 0; kb < 2; ++kb) {
#pragma unroll
                for (int i = 0; i < 16; ++i) s[kb][i] = 0.f;
#pragma unroll
                for (int ds = 0; ds < 4; ++ds) {
                    const bf16x8 a = *(const bf16x8*)&sK[(kb * 32 + l31) * LDT + ds * 16 + hf * 8];
                    s[kb] = MFMA(a, qf[ds], s[kb]);
                }
            }
            const bool need_mask = (k0 + 63 > qbase);
            float mloc = -INFINITY;
#pragma unroll
            for (int kb = 0; kb < 2; ++kb)
#pragma unroll
                for (int q = 0; q < 4; ++q) {
                    const f32x4 nb = *(const f32x4*)&sNb[kb * 32 + 8 * q + 4 * hf];
#pragma unroll
                    for (int i = 0; i < 4; ++i) {
                        float z = s[kb][4 * q + i] * c1 + nb[i];
                        if (need_mask) { const int key = k0 + kb * 32 + 8 * q + 4 * hf + i; z = (key > qrow) ? -INFINITY : z; }
                        s[kb][4 * q + i] = z;
                        mloc = fmaxf(mloc, z);
                    }
                }
            mloc = fmaxf(mloc, __shfl_xor(mloc, 32, 64));
            const float mnew = fmaxf(m, mloc);
            const float alpha = __builtin_amdgcn_exp2f(m - mnew);
            m = mnew;
            float ps = 0.f;
#pragma unroll
            for (int kb = 0; kb < 2; ++kb)
#pragma unroll
                for (int i = 0; i < 16; ++i) { const float p = __builtin_amdgcn_exp2f(s[kb][i] - mnew); s[kb][i] = p; ps += p; }
            lsum = lsum * alpha + ps;
#pragma unroll
            for (int i = 0; i < 16; ++i) { o[0][i] *= alpha; o[1][i] *= alpha; }
#pragma unroll
            for (int kb = 0; kb < 2; ++kb)
#pragma unroll
                for (int st = 0; st < 2; ++st) {
                    u32x4 pw;
                    pw[0] = pk2(s[kb][8 * st + 0], s[kb][8 * st + 1]); pw[1] = pk2(s[kb][8 * st + 2], s[kb][8 * st + 3]);
                    pw[2] = pk2(s[kb][8 * st + 4], s[kb][8 * st + 5]); pw[3] = pk2(s[kb][8 * st + 6], s[kb][8 * st + 7]);
                    const bf16x8 pf = __builtin_bit_cast(bf16x8, pw);
#pragma unroll
                    for (int db = 0; db < 2; ++db) {
                        const u16* vp = &sV[(db * 32 + l31) * LDT + kb * 32 + 16 * st + 4 * hf];
                        const u32x2 v0 = *(const u32x2*)vp, v1 = *(const u32x2*)(vp + 8);
                        u32x4 vw = {v0[0], v0[1], v1[0], v1[1]};
                        o[db] = MFMA(__builtin_bit_cast(bf16x8, vw), pf, o[db]);
                    }
                }
        }
    }
    lsum += __shfl_xor(lsum, 32, 64);
    const float inv = 1.f / lsum;
    u16* AATT = (u16*)(P.ws + OFF_Q);
#pragma unroll
    for (int db = 0; db < 2; ++db)
#pragma unroll
        for (int q = 0; q < 4; ++q) {
            const int d = db * 32 + 8 * q + 4 * hf;
            const u32x2 zw = *(const u32x2*)&ZA[tokq * 512 + h * 64 + d];
            u32x2 ow;
            ow[0] = pk2(o[db][4 * q] * inv * bflo(zw[0]), o[db][4 * q + 1] * inv * bfhi(zw[0]));
            ow[1] = pk2(o[db][4 * q + 2] * inv * bflo(zw[1]), o[db][4 * q + 3] * inv * bfhi(zw[1]));
            *(u32x2*)&AATT[tokq * 512 + h * 64 + d] = ow;
        }
}

DI float gelu_tanh(float y) {
    const float u = 0.7978845608028654f * (y + 0.044715f * y * y * y);
    const float e = __expf(2.f * u);
    const float th = 1.f - 2.f / (e + 1.f);
    return 0.5f * y * (1.f + th);
}
DI void pd_s5b(const Params& P, int g, int mt, int nt, u16* smem) {
    const u16* XS = (const u16*)(P.ws + OFF_XS);
    const u16* KU = (const u16*)(P.ws + OFF_KUNIQ) + (size_t)g * 64 * 256;
    const u16* WCT = (const u16*)(P.ws + OFF_WCT) + ((size_t)g * 1024 + nt * 128) * 128;
    const u16* HIN = (const u16*)(P.ws + OFF_HIN) + ((size_t)g * 256 + mt * 128) * 128;
    const int nkT = 2 * nt + 2;
    const int m0 = mt * 128;
    f32x16 acc[2][2];
    zero_acc<2>(acc);
    gemm_mainloop<2>(acc, nkT + 2,
        [=](int r, int ks, int c) {
            if (ks < nkT) { const int m = m0 + r, tok = (m >> 5) * 2048 + (m & 31) * 64 + ks * 4 + (c >> 1);
                            return ldg16(XS + (size_t)tok * 512 + g * 16 + (c & 1) * 8); }
            return ldg16(HIN + (size_t)r * 128 + (ks - nkT) * 64 + c * 8); },
        [=](int r, int ks, int c) {
            if (ks < nkT) { const int ng = nt * 128 + r, t = ng >> 4, ho = ng & 15, s = ks * 4 + (c >> 1), lag = t - s;
                            if (lag < 0) return zero4();
                            return ldg16(KU + (lag * 16 + ho) * 16 + (c & 1) * 8); }
            return ldg16(WCT + (size_t)r * 128 + (ks - nkT) * 64 + c * 8); },
        smem, smem + 128 * LDT);
    u16* YS = (u16*)(P.ws + OFF_K);
    const int lane = threadIdx.x & 63, w = threadIdx.x >> 6, wr = w >> 1, wc = w & 1, hf = lane >> 5;
#pragma unroll
    for (int mi = 0; mi < 2; ++mi)
#pragma unroll
        for (int ni = 0; ni < 2; ++ni) {
            const int ng = nt * 128 + wc * 64 + ni * 32 + (lane & 31), t = ng >> 4, ho = ng & 15;
#pragma unroll
            for (int i = 0; i < 16; ++i) {
                const int m = m0 + wr * 64 + mi * 32 + (i & 3) + 8 * (i >> 2) + 4 * hf;
                const size_t tok = (size_t)(m >> 5) * 2048 + (m & 31) * 64 + t;
                YS[tok * 512 + g * 16 + ho] = f2bf(gelu_tanh(acc[mi][ni][i]));
            }
        }
}

DI void pe_glu(const Params& P, int mt, int nt, u16* smem) {
    const u16* YS = (const u16*)(P.ws + OFF_K) + (size_t)mt * 128 * 512;
    const u16* W = (const u16*)(P.ws + OFF_WGLUT) + (size_t)nt * 128 * 512;
    f32x16 acc[2][2];
    zero_acc<2>(acc);
    gemm_mainloop<2>(acc, 8,
        [=](int r, int ks, int c) { return ldg16(YS + (size_t)r * 512 + ks * 64 + c * 8); },
        [=](int r, int ks, int c) { return ldg16(W + (size_t)r * 512 + ks * 64 + c * 8); },
        smem, smem + 128 * LDT);
    const u16* ZS = (const u16*)(P.ws + OFF_ZS);
    u16* AS = (u16*)(P.ws + OFF_VT);
    const int lane = threadIdx.x & 63, w = threadIdx.x >> 6, wr = w >> 1, wc = w & 1, hf = lane >> 5;
    const int ch = nt * 64 + wc * 32 + (lane & 31);
#pragma unroll
    for (int mi = 0; mi < 2; ++mi)
#pragma unroll
        for (int i = 0; i < 16; ++i) {
            const size_t row = (size_t)mt * 128 + wr * 64 + mi * 32 + (i & 3) + 8 * (i >> 2) + 4 * hf;
            const float v = acc[mi][0][i] * sigmoidf_(acc[mi][1][i]) * bf2f(ZS[row * 512 + ch]);
            AS[row * 512 + ch] = f2bf(v);
        }
}

DI void pf_merge(const Params& P, int mt, int nt, u16* smem) {
    const u16* AS = (const u16*)(P.ws + OFF_VT) + (size_t)mt * 128 * 512;
    const u16* AA = (const u16*)(P.ws + OFF_Q) + (size_t)mt * 128 * 512;
    const u16* W1 = (const u16*)(P.ws + OFF_WPST) + (size_t)nt * 128 * 512;
    const u16* W2 = (const u16*)(P.ws + OFF_WPAT) + (size_t)nt * 128 * 512;
    f32x16 acc1[2][2], acc2[2][2];
    zero_acc<2>(acc1); zero_acc<2>(acc2);
    gemm_mainloop<2>(acc1, 8,
        [=](int r, int ks, int c) { return ldg16(AS + (size_t)r * 512 + ks * 64 + c * 8); },
        [=](int r, int ks, int c) { return ldg16(W1 + (size_t)r * 512 + ks * 64 + c * 8); },
        smem, smem + 128 * LDT);
    gemm_mainloop<2>(acc2, 8,
        [=](int r, int ks, int c) { return ldg16(AA + (size_t)r * 512 + ks * 64 + c * 8); },
        [=](int r, int ks, int c) { return ldg16(W2 + (size_t)r * 512 + ks * 64 + c * 8); },
        smem, smem + 128 * LDT);
    const u16* GS = (const u16*)(P.ws + OFF_GS);
    const u16* GA = (const u16*)(P.ws + OFF_GA);
    u16* MG = (u16*)(P.ws + OFF_U);
    const int lane = threadIdx.x & 63, w = threadIdx.x >> 6, wr = w >> 1, wc = w & 1, hf = lane >> 5;
#pragma unroll
    for (int mi = 0; mi < 2; ++mi)
#pragma unroll
        for (int ni = 0; ni < 2; ++ni) {
            const int col = nt * 128 + wc * 64 + ni * 32 + (lane & 31);
#pragma unroll
            for (int i = 0; i < 16; ++i) {
                const size_t row = (size_t)mt * 128 + wr * 64 + mi * 32 + (i & 3) + 8 * (i >> 2) + 4 * hf;
                const float v = bf2f(GS[row * 1024 + col]) * acc1[mi][ni][i] + bf2f(GA[row * 1024 + col]) * acc2[mi][ni][i];
                MG[row * 1024 + col] = f2bf(v);
            }
        }
}

DI void pg_out(const Params& P, int mt, int nt, u16* smem) {
    const u16* MG = (const u16*)(P.ws + OFF_U) + (size_t)mt * 128 * 1024;
    const u16* W = (const u16*)(P.ws + OFF_WOUTT) + (size_t)nt * 128 * 1024;
    f32x16 acc[2][2];
    zero_acc<2>(acc);
    gemm_mainloop<2>(acc, 16,
        [=](int r, int ks, int c) { return ldg16(MG + (size_t)r * 1024 + ks * 64 + c * 8); },
        [=](int r, int ks, int c) { return ldg16(W + (size_t)r * 1024 + ks * 64 + c * 8); },
        smem, smem + 128 * LDT);
    const int lane = threadIdx.x & 63, w = threadIdx.x >> 6, wr = w >> 1, wc = w & 1, hf = lane >> 5;
    const int b = (mt * 128) >> 11;
    const float* gate = (const float*)(P.ws + OFF_MOD) + b * 3072 + 2048;
#pragma unroll
    for (int mi = 0; mi < 2; ++mi)
#pragma unroll
        for (int ni = 0; ni < 2; ++ni) {
            const int col = nt * 128 + wc * 64 + ni * 32 + (lane & 31);
            const float gt = gate[col];
#pragma unroll
            for (int i = 0; i < 16; ++i) {
                const size_t row = (size_t)mt * 128 + wr * 64 + mi * 32 + (i & 3) + 8 * (i >> 2) + 4 * hf;
                P.out[row * 1024 + col] = DN_ALPHA * P.x[row * 1024 + col] + acc[mi][ni][i] * gt;
            }
        }
}

DI void ph_ln(const Params& P, int row) {
    const int lane = threadIdx.x & 63;
    float* o = P.out + (size_t)row * 1024;
    f32x4 xv[4];
#pragma unroll
    for (int c = 0; c < 4; ++c) xv[c] = *(const f32x4*)&o[c * 256 + lane * 4];
    float s = 0.f;
#pragma unroll
    for (int c = 0; c < 4; ++c) s += (xv[c][0] + xv[c][1]) + (xv[c][2] + xv[c][3]);
    const float mu = wave_sum(s) * (1.f / 1024.f);
    float v = 0.f;
#pragma unroll
    for (int c = 0; c < 4; ++c)
#pragma unroll
        for (int i = 0; i < 4; ++i) { const float d = xv[c][i] - mu; v += d * d; }
    const float rstd = 1.f / sqrtf(wave_sum(v) * (1.f / 1024.f) + LN_EPS);
#pragma unroll
    for (int c = 0; c < 4; ++c) {
        const f32x4 g = *(const f32x4*)&P.ln_g[c * 256 + lane * 4], bb = *(const f32x4*)&P.ln_b[c * 256 + lane * 4];
        f32x4 r;
#pragma unroll
        for (int i = 0; i < 4; ++i) r[i] = (xv[c][i] - mu) * rstd * g[i] + bb[i];
        *(f32x4*)&o[c * 256 + lane * 4] = r;
    }
}

constexpr int SMEM_BYTES = 40960;
__global__ void __launch_bounds__(256, 2) fwd_megakernel(Params P) {
    __shared__ __attribute__((aligned(16))) unsigned char smem_raw[SMEM_BYTES + 16];
    const int tid = threadIdx.x, bid = blockIdx.x, nb = gridDim.x;
    volatile unsigned* st = (volatile unsigned*)(smem_raw + SMEM_BYTES);
    if (tid < 4) st[tid] = 0u;
    __syncthreads();
    XcdBarrier bar; bar.bar = (unsigned*)(P.ws + OFF_BAR); bar.x = xb_xcc_id(); bar.st = st;
    if (tid == 0) (void)xb_add(&bar.bar[XB_XCNT(bar.x)], 1u);
    u16* smem = (u16*)smem_raw;
    float* smemf = (float*)smem_raw;

    for (int it = bid; it < 96 + 256 + 1920; it += nb) {
        if (it < 96) pa_mod(P, it, smemf);
        else if (it < 352) { const int i2 = it - 96; pa_s5(P, i2 >> 3, i2 & 7, smemf); }
        else {
            int t = it - 352;
            if (t < 1280) pa_transpose(P.w_in, INCOLS, 1024, (u16*)(P.ws + OFF_WINT), 0, t / 80, t % 80, smem);
            else if ((t -= 1280) < 128) pa_transpose(P.w_glu, 1024, 512, (u16*)(P.ws + OFF_WGLUT), 1, t >> 4, t & 15, smem);
            else if ((t -= 128) < 128) pa_transpose(P.w_ps, 1024, 512, (u16*)(P.ws + OFF_WPST), 2, t >> 4, t & 15, smem);
            else if ((t -= 128) < 128) pa_transpose(P.w_pa, 1024, 512, (u16*)(P.ws + OFF_WPAT), 2, t >> 4, t & 15, smem);
            else { t -= 128; pa_transpose(P.w_out, 1024, 1024, (u16*)(P.ws + OFF_WOUTT), 2, t >> 4, t & 15, smem); }
        }
    }
    xcd_barrier(bar);
    {
        __syncthreads();
        for (int i = tid; i < 8192; i += 256) { const int k = i >> 3, h = i & 7; smemf[h * 1024 + k] = P.w_in[(size_t)k * INCOLS + 2560 + h]; }
        __syncthreads();
        for (int it = bid; it < 512; it += nb) pa2_rows(P, it, smemf);
    }
    xcd_barrier(bar);
    for (int it = bid; it < 64; it += nb) pb_cumsum(P, it, smemf);
    for (int it = bid; it < 5120; it += nb) pb_gemm1(P, it / 40, it % 40, smem);
    xcd_barrier(bar);
    for (int it = bid; it < 128; it += nb) pc_s5a(P, it >> 2, it & 3, smem);
    for (int it = bid; it < 1024; it += nb) {
        const int qt = (it < 512) ? (15 - (it >> 6)) : ((it - 512) >> 6);
        const int bh = it & 63;
        pc_attn(P, bh >> 3, bh & 7, qt, smem);
    }
    xcd_barrier(bar);
    for (int it = bid; it < 512; it += nb) { const int nt = 7 - (it >> 6), r = it & 63; pd_s5b(P, r >> 1, r & 1, nt, smem); }
    xcd_barrier(bar);
    for (int it = bid; it < 1024; it += nb) pe_glu(P, it >> 3, it & 7, smem);
    xcd_barrier(bar);
    for (int it = bid; it < 1024; it += nb) pf_merge(P, it >> 3, it & 7, smem);
    xcd_barrier(bar);
    for (int it = bid; it < 1024; it += nb) pg_out(P, it >> 3, it & 7, smem);
    xcd_barrier(bar);
    for (int row = bid * 4 + (tid >> 6); row < NTOK; row += nb * 4) ph_ln(P, row);
}

extern "C" void kernel_launch(void* const* d_in, const int* in_sizes, int n_in, void* d_out, int out_size, void* d_ws, size_t ws_size, hipStream_t stream) {
    static int grid = 0;
    if (grid == 0) {
        if (ws_size < WS_END) { fprintf(stderr, "kernel_launch: workspace too small: %zu < %zu\n", ws_size, (size_t)WS_END); grid = -1; return; }
        int dev = 0, cus = 0, per_cu = 0;
        hipGetDevice(&dev);
        hipDeviceGetAttribute(&cus, hipDeviceAttributeMultiprocessorCount, dev);
        hipOccupancyMaxActiveBlocksPerMultiprocessor(&per_cu, (const void*)fwd_megakernel, 256, 0);
        if (per_cu < 1) { fprintf(stderr, "kernel_launch: occupancy query returned %d\n", per_cu); grid = -1; return; }
        if (per_cu > 2) per_cu = 2;
        grid = cus * per_cu;
    }
    if (grid < 0) return;
    hipMemsetAsync((char*)d_ws + OFF_BAR, 0, 16384, stream);
    Params p{};
    const float** pp = (const float**)&p;
    for (int i = 0; i < 20; ++i) pp[i] = (const float*)d_in[i];
    p.out = (float*)d_out; p.ws = (unsigned char*)d_ws;
    void* args[] = {&p};
    hipError_t e = hipLaunchCooperativeKernel((const void*)fwd_megakernel, dim3(grid), dim3(256), args, 0, stream);
    if (e != hipSuccess) fprintf(stderr, "cooperative launch failed: %s (grid %d)\n", hipGetErrorString(e), grid);
}
```

```cpp
#include <hip/hip_runtime.h>
#include <stdio.h>
#include <stdint.h>

#define DI __device__ __forceinline__
__device__ __forceinline__ int tidx() { int t = threadIdx.x; asm volatile("" : "+v"(t)); return t; }
#define VTID (tidx() & 255)
typedef unsigned short u16;
using bf16x8 = __attribute__((ext_vector_type(8))) short;
using f32x16 = __attribute__((ext_vector_type(16))) float;
using f32x4  = __attribute__((ext_vector_type(4))) float;
using u32x4  = __attribute__((ext_vector_type(4))) unsigned;
using u32x2  = __attribute__((ext_vector_type(2))) unsigned;
typedef __bf16 bf16x2_t __attribute__((ext_vector_type(2)));
typedef float f32x2_t __attribute__((ext_vector_type(2)));

#define MFMA(a, b, c) __builtin_amdgcn_mfma_f32_32x32x16_bf16((a), (b), (c), 0, 0, 0)

DI unsigned pk2(float lo, float hi) { f32x2_t v = {lo, hi}; return __builtin_bit_cast(unsigned, __builtin_convertvector(v, bf16x2_t)); }
DI u16 f2bf(float x) { return (u16)(pk2(x, 0.f) & 0xffffu); }
DI float bf2f(unsigned h) { return __uint_as_float(h << 16); }
DI float bflo(unsigned w) { return __uint_as_float(w << 16); }
DI float bfhi(unsigned w) { return __uint_as_float(w & 0xffff0000u); }
DI float sigmoidf_(float x) { return 1.f / (1.f + __expf(-x)); }
DI float siluf_(float x) { return x / (1.f + __expf(-x)); }

constexpr int NTOK = 16384, SEQ = 2048, DM = 1024, INCOLS = 5128;
constexpr float LN_EPS = 1e-5f;
constexpr float DN_ALPHA = 1.189207115002721f;
constexpr float LOG2E = 1.4426950408889634f;

constexpr size_t OFF_BAR   = 0;
constexpr size_t OFF_MOD   = 16384;
constexpr size_t OFF_APL   = OFF_MOD + 98304;
constexpr size_t OFF_LOGF  = OFF_APL + 16384;
constexpr size_t OFF_CUMF  = OFF_LOGF + 524288;
constexpr size_t OFF_KUNIQ = OFF_CUMF + 524288;
constexpr size_t OFF_WST   = OFF_KUNIQ + 1048576;
constexpr size_t OFF_WCT   = OFF_WST + 8388608;
constexpr size_t OFF_HIN   = OFF_WCT + 8388608;
constexpr size_t OFF_WINT  = OFF_HIN + 2097152;
constexpr size_t OFF_WGLUT = OFF_WINT + 10485760;
constexpr size_t OFF_WPST  = OFF_WGLUT + 1048576;
constexpr size_t OFF_WPAT  = OFF_WPST + 1048576;
constexpr size_t OFF_WOUTT = OFF_WPAT + 1048576;
constexpr size_t OFF_U     = OFF_WOUTT + 2097152;
constexpr size_t OFF_XS    = OFF_U + 33554432;
constexpr size_t OFF_ZS    = OFF_XS + 16777216;
constexpr size_t OFF_Q     = OFF_ZS + 16777216;
constexpr size_t OFF_K     = OFF_Q + 16777216;
constexpr size_t OFF_VT    = OFF_K + 16777216;
constexpr size_t OFF_ZA    = OFF_VT + 16777216;
constexpr size_t OFF_GS    = OFF_ZA + 16777216;
constexpr size_t OFF_GA    = OFF_GS + 33554432;
constexpr size_t WS_END    = OFF_GA + 33554432;
constexpr size_t OFF_AB = OFF_U;
constexpr size_t OFF_MG = OFF_XS;

struct Params {
    const float *x, *c, *w_ada, *b_ada, *w_in, *b_f, *lam_re, *lam_im, *log_dt, *b_re, *b_im, *c_re, *c_im, *ssm_d,
                *w_glu, *w_ps, *w_pa, *w_out, *ln_g, *ln_b;
    float* out;
    unsigned char* ws;
};

#define XB_TMO      128
#define XB_XCNT(j)  (256  + 64 * (j))
#define XB_XSUB(j)  (1280 + 64 * (j))
#define XB_XGEN(j)  (2304 + 64 * (j))
#define XB_TOP      3328
#define XB_TOPGEN   3392
#define XCD_BAR_WORDS 3456
#define XB_SPIN_CAP (1u << 22)

DI unsigned xb_ld(unsigned* p)              { return __hip_atomic_load(p, __ATOMIC_RELAXED, __HIP_MEMORY_SCOPE_AGENT); }
DI unsigned xb_add(unsigned* p, unsigned v) { return __hip_atomic_fetch_add(p, v, __ATOMIC_RELAXED, __HIP_MEMORY_SCOPE_AGENT); }
DI unsigned xb_xcc_id() { return (unsigned)__builtin_amdgcn_s_getreg((3 << 11) | 20) & 0xFu; }
#define XB_SPIN(cond, bar) do { unsigned _sp = 0; while (cond) { __builtin_amdgcn_s_sleep(1); \
    if ((++_sp & 255u) == 0u) { if (xb_ld(&(bar)[XB_TMO])) break; if (_sp > XB_SPIN_CAP) { atomicAdd(&(bar)[XB_TMO], 1u); break; } } } } while (0)

struct XcdBarrier { unsigned* bar; unsigned x; volatile unsigned* st; };

DI void xcd_barrier_complete(unsigned* bar, unsigned x, unsigned& nloc, unsigned& nx) {
    const unsigned G = gridDim.x;
    unsigned sum, cnt, mine, sp = 0u;
    for (;;) {
        sum = 0u; cnt = 0u; mine = 0u;
#pragma unroll
        for (unsigned j = 0; j < 16; ++j) { const unsigned c = xb_ld(&bar[XB_XCNT(j)]); sum += c; cnt += (c > 0u) ? 1u : 0u; mine = (j == x) ? c : mine; }
        if (sum == G) break;
        __builtin_amdgcn_s_sleep(1);
        if ((++sp & 255u) == 0u) { if (xb_ld(&bar[XB_TMO])) break; if (sp > XB_SPIN_CAP) { atomicAdd(&bar[XB_TMO], 1u); break; } }
    }
    nloc = mine > 0u ? mine : 1u; nx = cnt > 0u ? cnt : 1u;
}

DI void xcd_barrier(const XcdBarrier& b) {
    asm volatile("s_waitcnt vmcnt(0)" ::: "memory");
    __syncthreads();
    if (threadIdx.x == 0) {
        unsigned* bar = b.bar;
        __builtin_amdgcn_s_waitcnt(0);
        unsigned nloc = b.st[0], nx = b.st[1];
        if (nloc == 0u) { xcd_barrier_complete(bar, b.x, nloc, nx); b.st[0] = nloc; b.st[1] = nx; }
        const unsigned old = xb_add(&bar[XB_XSUB(b.x)], 1u);
        const unsigned gen = old / nloc;
        if (old + 1u == (gen + 1u) * nloc) {
            __builtin_amdgcn_fence(__ATOMIC_RELEASE, "agent");
            asm volatile("s_waitcnt vmcnt(0)" ::: "memory");
            const unsigned og = xb_add(&bar[XB_TOP], 1u);
            const unsigned tg = og / nx;
            if (og + 1u == (tg + 1u) * nx) xb_add(&bar[XB_TOPGEN], 1u);
            else XB_SPIN(xb_ld(&bar[XB_TOPGEN]) == tg, bar);
            __builtin_amdgcn_fence(__ATOMIC_ACQUIRE, "agent");
            xb_add(&bar[XB_XGEN(b.x)], 1u);
            asm volatile("s_waitcnt vmcnt(0)" ::: "memory");
        } else {
            XB_SPIN(xb_ld(&bar[XB_XGEN(b.x)]) == gen, bar);
            __builtin_amdgcn_fence(__ATOMIC_ACQUIRE, "agent");
            asm volatile("s_waitcnt vmcnt(0)" ::: "memory");
        }
    }
    __syncthreads();
}

DI float wave_sum(float v) {
#pragma unroll
    for (int o = 32; o > 0; o >>= 1) v += __shfl_xor(v, o, 64);
    return v;
}
DI u32x4 ldg16(const u16* p) { return *(const u32x4*)p; }
DI u32x4 zero4() { u32x4 z = {0u, 0u, 0u, 0u}; return z; }

constexpr int LDT = 72;
struct NoFix { DI u32x4 operator()(int, int, int, u32x4 v) const { return v; } };
template <int MT, class FA, class FB, class PB = NoFix>
DI void gemm_mainloop(f32x16 (&acc)[MT][2], int nk, FA fa, FB fb, u16* sA, u16* sB, PB pb = PB()) {
    const int tid = VTID, lane = tid & 63, w = tid >> 6, wr = w >> 1, wc = w & 1;
    const int cch = tid & 7, r0 = tid >> 3;
    u32x4 ra0[MT * 2], rb0[4], ra1[MT * 2], rb1[4];
#pragma unroll
    for (int i = 0; i < MT * 2; ++i) ra0[i] = fa(r0 + 32 * i, 0, cch);
#pragma unroll
    for (int i = 0; i < 4; ++i) rb0[i] = fb(r0 + 32 * i, 0, cch);
    if (nk > 1) {
#pragma unroll
        for (int i = 0; i < MT * 2; ++i) ra1[i] = fa(r0 + 32 * i, 1, cch);
#pragma unroll
        for (int i = 0; i < 4; ++i) rb1[i] = fb(r0 + 32 * i, 1, cch);
    }
#define GM_STEP(RA, RB, KS) do { \
        __syncthreads(); \
        _Pragma("unroll") for (int i = 0; i < MT * 2; ++i) *(u32x4*)&sA[(r0 + 32 * i) * LDT + cch * 8] = RA[i]; \
        _Pragma("unroll") for (int i = 0; i < 4; ++i) *(u32x4*)&sB[(r0 + 32 * i) * LDT + cch * 8] = pb(r0 + 32 * i, (KS), cch, RB[i]); \
        __syncthreads(); \
        if ((KS) + 2 < nk) { \
            _Pragma("unroll") for (int i = 0; i < MT * 2; ++i) RA[i] = fa(r0 + 32 * i, (KS) + 2, cch); \
            _Pragma("unroll") for (int i = 0; i < 4; ++i) RB[i] = fb(r0 + 32 * i, (KS) + 2, cch); \
        } \
        _Pragma("unroll") for (int kk = 0; kk < 4; ++kk) { \
            bf16x8 af[MT], bfr[2]; \
            _Pragma("unroll") for (int mi = 0; mi < MT; ++mi) af[mi] = *(const bf16x8*)&sA[(wr * 32 * MT + mi * 32 + (lane & 31)) * LDT + kk * 16 + (lane >> 5) * 8]; \
            _Pragma("unroll") for (int ni = 0; ni < 2; ++ni) bfr[ni] = *(const bf16x8*)&sB[(wc * 64 + ni * 32 + (lane & 31)) * LDT + kk * 16 + (lane >> 5) * 8]; \
            _Pragma("unroll") for (int mi = 0; mi < MT; ++mi) _Pragma("unroll") for (int ni = 0; ni < 2; ++ni) acc[mi][ni] = MFMA(af[mi], bfr[ni], acc[mi][ni]); \
        } } while (0)
    for (int ks = 0; ks < nk; ks += 2) {
        GM_STEP(ra0, rb0, ks);
        if (ks + 1 < nk) GM_STEP(ra1, rb1, ks + 1);
    }
#undef GM_STEP
}
template <int MT>
DI void zero_acc(f32x16 (&acc)[MT][2]) {
#pragma unroll
    for (int mi = 0; mi < MT; ++mi)
#pragma unroll
        for (int ni = 0; ni < 2; ++ni)
#pragma unroll
            for (int i = 0; i < 16; ++i) acc[mi][ni][i] = 0.f;
}

DI void pa_mod(const Params& P, int item, float* smem) {
    const int tid = VTID;
    float* sc = smem;
    float* red = smem + 8192;
    __syncthreads();
    for (int i = tid; i < 8192; i += 256) { const int b = i >> 10, k = i & 1023; sc[k * 8 + b] = siluf_(P.c[i]); }
    __syncthreads();
    const int nl = tid & 31, ks = tid >> 5, n = item * 32 + nl;
    float acc[8];
#pragma unroll
    for (int b = 0; b < 8; ++b) acc[b] = 0.f;
    for (int k = ks * 128; k < ks * 128 + 128; ++k) {
        const float wv = P.w_ada[(size_t)k * 3072 + n];
        const f32x4 s0 = *(const f32x4*)&sc[k * 8], s1 = *(const f32x4*)&sc[k * 8 + 4];
        acc[0] += s0[0] * wv; acc[1] += s0[1] * wv; acc[2] += s0[2] * wv; acc[3] += s0[3] * wv;
        acc[4] += s1[0] * wv; acc[5] += s1[1] * wv; acc[6] += s1[2] * wv; acc[7] += s1[3] * wv;
    }
#pragma unroll
    for (int b = 0; b < 8; ++b) red[(ks * 8 + b) * 32 + nl] = acc[b];
    __syncthreads();
    {
        const int b = tid >> 5;
        float s = P.b_ada[n];
#pragma unroll
        for (int k2 = 0; k2 < 8; ++k2) s += red[(k2 * 8 + b) * 32 + nl];
        ((float*)(P.ws + OFF_MOD))[b * 3072 + n] = s;
    }
}

DI int srccol(int mode, int n) {
    if (mode == 0) return n < 2048 ? n : (n < 4608 ? n + 520 : n - 2560);
    if (mode == 1) { const int pn = n >> 8, bj = (n >> 7) & 1, j = n & 127; return bj * 512 + pn * 128 + j; }
    return n;
}
DI void pa_transpose(const float* src, int ld, int K, u16* dst, int mode, int kt, int nt, u16* sT) {
    const int tid = VTID;
    __syncthreads();
    const int nl = tid & 63, kq = tid >> 6;
    const int sc = srccol(mode, nt * 64 + nl);
#pragma unroll
    for (int r = 0; r < 16; ++r) {
        const int k = r * 4 + kq;
        sT[k * 66 + nl] = f2bf(src[(size_t)(kt * 64 + k) * ld + sc]);
    }
    __syncthreads();
    const int n = tid >> 2, kc = (tid & 3) * 16;
    unsigned v[8];
#pragma unroll
    for (int j = 0; j < 8; ++j) v[j] = (unsigned)sT[(kc + 2 * j) * 66 + n] | ((unsigned)sT[(kc + 2 * j + 1) * 66 + n] << 16);
    u16* d = dst + (size_t)(nt * 64 + n) * K + kt * 64 + kc;
    u32x4 o0 = {v[0], v[1], v[2], v[3]}, o1 = {v[4], v[5], v[6], v[7]};
    *(u32x4*)d = o0; *(u32x4*)(d + 8) = o1;
}

DI void pa_s5(const Params& P, int g, int j, int part, float* smem) {
    const int tid = VTID;
    f32x2_t* sAp = (f32x2_t*)smem;
    f32x2_t* sBb = sAp + 64 * 9;
    f32x2_t* sC  = sBb + 64 * 16;
    f32x2_t* sCo = sC + 16 * 64;
    __syncthreads();
    const float dt = expf(P.log_dt[g]);
    if (tid < 64) {
        const float lr = P.lam_re[g * 64 + tid], li = P.lam_im[g * 64 + tid];
        const float th = li * dt, lm = lr * dt;
        double a = (double)th; a -= 6.283185307179586 * __builtin_rint(a * 0.15915494309189535);
        const float rr = (float)a, mag = expf(lm);
        const float abr = mag * cosf(rr), abi = mag * sinf(rr);
        const float den = lr * lr + li * li;
        f32x2_t co; co[0] = ((abr - 1.f) * lr + abi * li) / den; co[1] = (abi * lr - (abr - 1.f) * li) / den;
        sCo[tid] = co;
    }
    for (int i = tid; i < 576; i += 256) {
        const int p = i / 9, el = i % 9, e = 8 * j + el;
        const float lr = P.lam_re[g * 64 + p], li = P.lam_im[g * 64 + p];
        const float th = li * dt, lm = lr * dt;
        double a = (double)e * (double)th; a -= 6.283185307179586 * __builtin_rint(a * 0.15915494309189535);
        const float rr = (float)a, mag = expf((float)e * lm);
        f32x2_t v; v[0] = mag * cosf(rr); v[1] = mag * sinf(rr);
        sAp[p * 9 + el] = v;
    }
    __syncthreads();
    for (int i = tid; i < 1024; i += 256) {
        const int p = i >> 4, hi = i & 15;
        const float br = P.b_re[(g * 64 + p) * 16 + hi], bi = P.b_im[(g * 64 + p) * 16 + hi];
        const f32x2_t co = sCo[p];
        f32x2_t v; v[0] = co[0] * br - co[1] * bi; v[1] = co[0] * bi + co[1] * br;
        sBb[p * 16 + hi] = v;
        const int ho = i >> 6, p2 = i & 63;
        f32x2_t cv; cv[0] = P.c_re[(g * 16 + ho) * 64 + p2]; cv[1] = P.c_im[(g * 16 + ho) * 64 + p2];
        sC[ho * 64 + p2] = cv;
    }
    __syncthreads();
    if (part == 0) {
        const int ho = tid >> 4, hi = tid & 15;
        float acc[8];
#pragma unroll
        for (int l = 0; l < 8; ++l) acc[l] = 0.f;
        for (int p = 0; p < 64; ++p) {
            const f32x2_t cv = sC[ho * 64 + p], bb = sBb[p * 16 + hi];
            const float cbr = cv[0] * bb[0] - cv[1] * bb[1], cbi = cv[0] * bb[1] + cv[1] * bb[0];
#pragma unroll
            for (int l = 0; l < 8; ++l) { const f32x2_t ap = sAp[p * 9 + l]; acc[l] += cbr * ap[0] - cbi * ap[1]; }
        }
        if (j == 0 && ho == hi) acc[0] += P.ssm_d[g * 16 + ho];
        u16* ku = (u16*)(P.ws + OFF_KUNIQ);
#pragma unroll
        for (int l = 0; l < 8; ++l) ku[((g * 64 + 8 * j + l) * 16 + ho) * 16 + hi] = f2bf(acc[l]);
    }
    if (part == 1) {
        u16* wst = (u16*)(P.ws + OFF_WST);
        for (int idx = tid; idx < 16384; idx += 256) {
            const int hi = idx & 15, sl = (idx >> 4) & 7, n = idx >> 7, p = n >> 1, ri = n & 1;
            const f32x2_t ap = sAp[p * 9 + (7 - sl)], bb = sBb[p * 16 + hi];
            const float v = ri ? (ap[0] * bb[1] + ap[1] * bb[0]) : (ap[0] * bb[0] - ap[1] * bb[1]);
            wst[(size_t)(g * 128 + n) * 1024 + (56 - 8 * j + sl) * 16 + hi] = f2bf(v);
        }
    }
    if (part == 2) {
        u16* wct = (u16*)(P.ws + OFF_WCT);
        for (int idx = tid; idx < 16384; idx += 256) {
            const int k = idx & 127, ho = (idx >> 7) & 15, tl = idx >> 11, p = k >> 1, ri = k & 1;
            const f32x2_t ap = sAp[p * 9 + tl + 1], cv = sC[ho * 64 + p];
            const float v = ri ? -(cv[0] * ap[1] + cv[1] * ap[0]) : (cv[0] * ap[0] - cv[1] * ap[1]);
            wct[(size_t)(g * 1024 + (8 * j + tl) * 16 + ho) * 128 + k] = f2bf(v);
        }
    }
    if (part == 2 && j == 7 && tid < 64) ((f32x2_t*)(P.ws + OFF_APL))[g * 64 + tid] = sAp[tid * 9 + 8];
}

DI void pa2_rows(const Params& P, int item, const float* sWf) {
    const int tid = VTID, lane = tid & 63, w = tid >> 6;
    const int row0 = item * 32 + w * 8, b = row0 >> 11;
    const float* mod = (const float*)(P.ws + OFF_MOD) + b * 3072;
    f32x4 sh[4], sc[4];
#pragma unroll
    for (int c = 0; c < 4; ++c) {
        sh[c] = *(const f32x4*)&mod[c * 256 + lane * 4];
        sc[c] = *(const f32x4*)&mod[1024 + c * 256 + lane * 4];
    }
    u16* U = (u16*)(P.ws + OFF_U);
    float* logf = (float*)(P.ws + OFF_LOGF);
    f32x4 xn[4];
#pragma unroll
    for (int c = 0; c < 4; ++c) xn[c] = *(const f32x4*)&P.x[(size_t)row0 * 1024 + c * 256 + lane * 4];
    for (int r = 0; r < 8; ++r) {
        const int row = row0 + r;
        f32x4 xv[4];
#pragma unroll
        for (int c = 0; c < 4; ++c) xv[c] = xn[c];
        if (r + 1 < 8) {
#pragma unroll
            for (int c = 0; c < 4; ++c) xn[c] = *(const f32x4*)&P.x[(size_t)(row + 1) * 1024 + c * 256 + lane * 4];
        }
        float s = 0.f;
#pragma unroll
        for (int c = 0; c < 4; ++c) s += (xv[c][0] + xv[c][1]) + (xv[c][2] + xv[c][3]);
        const float mu = wave_sum(s) * (1.f / 1024.f);
        float v = 0.f;
#pragma unroll
        for (int c = 0; c < 4; ++c)
#pragma unroll
            for (int i = 0; i < 4; ++i) { const float d = xv[c][i] - mu; v += d * d; }
        const float rstd = 1.f / sqrtf(wave_sum(v) * (1.f / 1024.f) + LN_EPS);
        float part[8];
#pragma unroll
        for (int h = 0; h < 8; ++h) part[h] = 0.f;
#pragma unroll
        for (int c = 0; c < 4; ++c) {
            f32x4 u;
#pragma unroll
            for (int i = 0; i < 4; ++i) u[i] = (xv[c][i] - mu) * rstd * (1.f + sc[c][i]) + sh[c][i];
            u32x2 o; o[0] = pk2(u[0], u[1]); o[1] = pk2(u[2], u[3]);
            *(u32x2*)&U[(size_t)row * 1024 + c * 256 + lane * 4] = o;
#pragma unroll
            for (int h = 0; h < 8; ++h) {
                const f32x4 wv = *(const f32x4*)&sWf[h * 1024 + c * 256 + lane * 4];
                part[h] += u[0] * wv[0] + u[1] * wv[1] + u[2] * wv[2] + u[3] * wv[3];
            }
        }
        float f;
        {
            float q4[4], q2[2];
#pragma unroll
            for (int i = 0; i < 4; ++i) { const float keep = (lane & 1) ? part[2 * i + 1] : part[2 * i], give = (lane & 1) ? part[2 * i] : part[2 * i + 1]; q4[i] = keep + __shfl_xor(give, 1, 64); }
#pragma unroll
            for (int i = 0; i < 2; ++i) { const float keep = (lane & 2) ? q4[2 * i + 1] : q4[2 * i], give = (lane & 2) ? q4[2 * i] : q4[2 * i + 1]; q2[i] = keep + __shfl_xor(give, 2, 64); }
            { const float keep = (lane & 4) ? q2[1] : q2[0], give = (lane & 4) ? q2[0] : q2[1]; f = keep + __shfl_xor(give, 4, 64); }
            f += __shfl_xor(f, 8, 64); f += __shfl_xor(f, 16, 64); f += __shfl_xor(f, 32, 64);
        }
        if (lane < 8) {
            const float z = f + P.b_f[lane];
            const float lf = fminf(z, 0.f) - log1pf(expf(-fabsf(z)));
            logf[(size_t)(b * 8 + lane) * 2048 + (row & 2047)] = lf;
        }
    }
}

DI void pb_cumsum(const Params& P, int seq, float* smem) {
    const int tid = VTID;
    const float* lf = (const float*)(P.ws + OFF_LOGF) + (size_t)seq * 2048;
    float* cf = (float*)(P.ws + OFF_CUMF) + (size_t)seq * 2048;
    __syncthreads();
    f32x4 a = *(const f32x4*)&lf[tid * 8], b4 = *(const f32x4*)&lf[tid * 8 + 4];
    float v[8] = {a[0], a[1], a[2], a[3], b4[0], b4[1], b4[2], b4[3]};
#pragma unroll
    for (int i = 1; i < 8; ++i) v[i] += v[i - 1];
    smem[tid] = v[7];
    __syncthreads();
    if (tid == 0) { float run = 0.f; for (int i = 0; i < 256; ++i) { const float t = smem[i]; smem[i] = run; run += t; } }
    __syncthreads();
    const float off = smem[tid];
    f32x4 o0 = {v[0] + off, v[1] + off, v[2] + off, v[3] + off}, o1 = {v[4] + off, v[5] + off, v[6] + off, v[7] + off};
    *(f32x4*)&cf[tid * 8] = o0; *(f32x4*)&cf[tid * 8 + 4] = o1;
}

using f32x4v = __attribute__((ext_vector_type(4))) float;
DI void pc_s5a2(const Params& P, int g, int b, float* sH  ) {
    const int tid = threadIdx.x, lane = tid & 63, w = tid >> 6, fr = lane & 15, fq = lane >> 4;
    const u16* A = (const u16*)(P.ws + OFF_XS) + ((size_t)(g * 256 + b * 32)) * 1024;
    const u16* Bw = (const u16*)(P.ws + OFF_WST) + ((size_t)g * 128 + w * 16) * 1024;
    f32x4v acc0 = {0.f, 0.f, 0.f, 0.f}, acc1 = {0.f, 0.f, 0.f, 0.f};
    const u16* a0p = A + (size_t)fr * 1024 + fq * 8;
    const u16* a1p = A + (size_t)(16 + fr) * 1024 + fq * 8;
    const u16* bp = Bw + (size_t)fr * 1024 + fq * 8;
#pragma unroll 8
    for (int ks = 0; ks < 32; ++ks) {
        const bf16x8 a0 = *(const bf16x8*)(a0p + ks * 32), a1 = *(const bf16x8*)(a1p + ks * 32), bb = *(const bf16x8*)(bp + ks * 32);
        acc0 = __builtin_amdgcn_mfma_f32_16x16x32_bf16(a0, bb, acc0, 0, 0, 0);
        acc1 = __builtin_amdgcn_mfma_f32_16x16x32_bf16(a1, bb, acc1, 0, 0, 0);
    }
    __syncthreads();
#pragma unroll
    for (int j = 0; j < 4; ++j) {
        sH[(fq * 4 + j) * 132 + w * 16 + fr] = acc0[j];
        sH[(16 + fq * 4 + j) * 132 + w * 16 + fr] = acc1[j];
    }
    __syncthreads();
    if (tid < 64) {
        const int p = tid;
        const f32x2_t al = ((const f32x2_t*)(P.ws + OFF_APL))[g * 64 + p];
        u16* HIN = (u16*)(P.ws + OFF_HIN);
        float hr = 0.f, hi = 0.f;
        for (int c = 0; c < 32; ++c) {
            *(unsigned*)&HIN[(size_t)(g * 256 + b * 32 + c) * 128 + 2 * p] = pk2(hr, hi);
            const float er = sH[c * 132 + 2 * p], ei = sH[c * 132 + 2 * p + 1];
            const float nr = al[0] * hr - al[1] * hi + er, ni2 = al[0] * hi + al[1] * hr + ei;
            hr = nr; hi = ni2;
        }
    }
}

constexpr int ATT_BUF = 64 * LDT * 2 * 2 + 256;
struct AttStage { u32x4 k, v; float nb; };
DI void att_load(AttStage& r, const u16* Kb, const u16* Vb, const float* CF, int t, int tid) {
    const int row = tid >> 3, c = tid & 7;
    r.k = ldg16(Kb + (size_t)(t * 64 + row) * 512 + c * 8);
    r.v = ldg16(Vb + (size_t)row * 16384 + t * 64 + c * 8);
    r.nb = CF[t * 64 + (tid & 63)];
}
constexpr int LDV = 68;
DI void att_store(const AttStage& r, unsigned char* buf, int tid) {
    const int row = tid >> 3, c = tid & 7;
    *(u32x4*)(buf + (row * LDT + c * 8) * 2) = r.k;
    u32x2 v0 = {r.v[0], r.v[1]}, v1 = {r.v[2], r.v[3]};
    *(u32x2*)(buf + 64 * LDT * 2 + (row * LDV + c * 8) * 2) = v0;
    *(u32x2*)(buf + 64 * LDT * 2 + (row * LDV + c * 8 + 4) * 2) = v1;
    if (tid < 64) *(float*)(buf + 64 * LDT * 4 + tid * 4) = -r.nb * LOG2E;
}
DI void att_s(f32x16 (&s)[2], const unsigned char* buf, int l31, int hf, const bf16x8 (&qf)[4]) {
    const u16* sK = (const u16*)buf;
    const float* sNb = (const float*)(buf + 64 * LDT * 4);
    bf16x8 kf[2][4];
#pragma unroll
    for (int kb = 0; kb < 2; ++kb)
#pragma unroll
        for (int ds = 0; ds < 4; ++ds) kf[kb][ds] = *(const bf16x8*)&sK[(kb * 32 + l31) * LDT + ds * 16 + hf * 8];
#pragma unroll
    for (int kb = 0; kb < 2; ++kb)
#pragma unroll
        for (int q = 0; q < 4; ++q) {
            const f32x4 nb = *(const f32x4*)&sNb[kb * 32 + 8 * q + 4 * hf];
            s[kb][4 * q] = nb[0]; s[kb][4 * q + 1] = nb[1]; s[kb][4 * q + 2] = nb[2]; s[kb][4 * q + 3] = nb[3];
        }
#pragma unroll
    for (int ds = 0; ds < 4; ++ds)
#pragma unroll
        for (int kb = 0; kb < 2; ++kb) s[kb] = MFMA(kf[kb][ds], qf[ds], s[kb]);
}
DI void att_pv(f32x16 (&s)[2], const unsigned char* buf, int k0, int qbase, int qrow, int l31, int hf, f32x16 (&o)[2], float& m, float& lsum) {
    const u16* sV = (const u16*)(buf + 64 * LDT * 2);
    if (__builtin_amdgcn_readfirstlane((int)(k0 + 63 > qbase))) {
#pragma unroll
        for (int kb = 0; kb < 2; ++kb)
#pragma unroll
            for (int i = 0; i < 16; ++i) { const int key = k0 + kb * 32 + (i & 3) + 8 * (i >> 2) + 4 * hf; s[kb][i] = (key > qrow) ? -INFINITY : s[kb][i]; }
    }
    float mloc = s[0][0];
    asm("v_max3_f32 %0, %0, %1, %2" : "+v"(mloc) : "v"(s[1][0]), "v"(s[0][1]));
#pragma unroll
    for (int i = 1; i < 15; ++i) asm("v_max3_f32 %0, %0, %1, %2" : "+v"(mloc) : "v"(s[1][i]), "v"(s[0][i + 1]));
    asm("v_max_f32 %0, %0, %1" : "+v"(mloc) : "v"(s[1][15]));
    mloc = fmaxf(mloc, __shfl_xor(mloc, 32, 64));
    const float mnew = fmaxf(m, mloc);
    const float alpha = __builtin_amdgcn_exp2f(m - mnew);
    m = mnew;
    float ps = 0.f;
#pragma unroll
    for (int kb = 0; kb < 2; ++kb)
#pragma unroll
        for (int i = 0; i < 16; ++i) { const float p = __builtin_amdgcn_exp2f(s[kb][i] - mnew); s[kb][i] = p; ps += p; }
    lsum = lsum * alpha + ps;
#pragma unroll
    for (int i = 0; i < 16; ++i) { o[0][i] *= alpha; o[1][i] *= alpha; }
#pragma unroll
    for (int kb = 0; kb < 2; ++kb)
#pragma unroll
        for (int st = 0; st < 2; ++st) {
            u32x4 pw;
            pw[0] = pk2(s[kb][8 * st + 0], s[kb][8 * st + 1]); pw[1] = pk2(s[kb][8 * st + 2], s[kb][8 * st + 3]);
            pw[2] = pk2(s[kb][8 * st + 4], s[kb][8 * st + 5]); pw[3] = pk2(s[kb][8 * st + 6], s[kb][8 * st + 7]);
            const bf16x8 pf = __builtin_bit_cast(bf16x8, pw);
#pragma unroll
            for (int db = 0; db < 2; ++db) {
                const u16* vp = &sV[(db * 32 + l31) * LDV + kb * 32 + 16 * st + 4 * hf];
                const u32x2 v0 = *(const u32x2*)vp, v1 = *(const u32x2*)(vp + 8);
                u32x4 vw = {v0[0], v0[1], v1[0], v1[1]};
                o[db] = MFMA(__builtin_bit_cast(bf16x8, vw), pf, o[db]);
            }
        }
}
DI void pc_attn3(const Params& P, int b, int h, int qblk, unsigned char* lds) {
    const int tid = threadIdx.x, lane = tid & 63, w = tid >> 6, hf = lane >> 5, l31 = lane & 31;
    const u16* Q = (const u16*)(P.ws + OFF_Q);
    const u16* ZA = (const u16*)(P.ws + OFF_ZA);
    const float* CF = (const float*)(P.ws + OFF_CUMF) + (size_t)(b * 8 + h) * 2048;
    const u16* Kb = (const u16*)(P.ws + OFF_K) + ((size_t)b * 2048) * 512 + h * 64;
    const u16* Vb = (const u16*)(P.ws + OFF_VT) + (size_t)(h * 64) * 16384 + (size_t)b * 2048;
    const int qbase = qblk * 256 + w * 32, qrow = qbase + l31;
    const size_t tokq = (size_t)b * 2048 + qrow;
    bf16x8 qf[4];
#pragma unroll
    for (int ds = 0; ds < 4; ++ds) qf[ds] = *(const bf16x8*)&Q[tokq * 512 + h * 64 + ds * 16 + hf * 8];
    f32x16 o[2], sa[2], sb[2];
#pragma unroll
    for (int i = 0; i < 16; ++i) { o[0][i] = 0.f; o[1][i] = 0.f; }
    float m = -INFINITY, lsum = 0.f;
    const int nkt = 4 * (qblk + 1);
    const int tlast = (qbase + 31) >> 6;
    AttStage r0, r1;
    att_load(r0, Kb, Vb, CF, 0, tid);
    att_load(r1, Kb, Vb, CF, 1, tid);
    __syncthreads();
    att_store(r0, lds, tid);
    att_store(r1, lds + ATT_BUF, tid);
    att_load(r0, Kb, Vb, CF, 2, tid);
    att_load(r1, Kb, Vb, CF, 3, tid);
    __syncthreads();
    att_s(sa, lds, l31, hf, qf);
    int b0 = 0, b1 = 1, b2 = 2;
    for (int t = 0; t < nkt; t += 2) {
        __syncthreads();
        if (t + 2 < nkt) { att_store(r0, lds + b2 * ATT_BUF, tid); if (t + 4 < nkt) att_load(r0, Kb, Vb, CF, t + 4, tid); }
        if (t + 1 <= tlast) att_s(sb, lds + b1 * ATT_BUF, l31, hf, qf);
        __builtin_amdgcn_sched_barrier(0);
        if (t <= tlast) att_pv(sa, lds + b0 * ATT_BUF, t * 64, qbase, qrow, l31, hf, o, m, lsum);
        __syncthreads();
        if (t + 3 < nkt) { att_store(r1, lds + b0 * ATT_BUF, tid); if (t + 5 < nkt) att_load(r1, Kb, Vb, CF, t + 5, tid); }
        if (t + 2 < nkt && t + 2 <= tlast) att_s(sa, lds + b2 * ATT_BUF, l31, hf, qf);
        __builtin_amdgcn_sched_barrier(0);
        if (t + 1 <= tlast) att_pv(sb, lds + b1 * ATT_BUF, (t + 1) * 64, qbase, qrow, l31, hf, o, m, lsum);
        { const int nb0 = b2, nb1 = b0, nb2 = b1; b0 = nb0; b1 = nb1; b2 = nb2; }
    }
    lsum += __shfl_xor(lsum, 32, 64);
    const float inv = 1.f / lsum;
    u16* AATT = (u16*)(P.ws + OFF_AB);
#pragma unroll
    for (int db = 0; db < 2; ++db)
#pragma unroll
        for (int q = 0; q < 4; ++q) {
            const int d = db * 32 + 8 * q + 4 * hf;
            const u32x2 zw = *(const u32x2*)&ZA[tokq * 512 + h * 64 + d];
            u32x2 ow;
            ow[0] = pk2(o[db][4 * q] * inv * bflo(zw[0]), o[db][4 * q + 1] * inv * bfhi(zw[0]));
            ow[1] = pk2(o[db][4 * q + 2] * inv * bflo(zw[1]), o[db][4 * q + 3] * inv * bfhi(zw[1]));
            *(u32x2*)&AATT[tokq * 1024 + 512 + h * 64 + d] = ow;
        }
}

DI float gelu_tanh(float y) {
    const float u = 0.7978845608028654f * (y + 0.044715f * y * y * y);
    const float e = __expf(2.f * u);
    const float th = 1.f - 2.f / (e + 1.f);
    return 0.5f * y * (1.f + th);
}
DI void pd_s5b(const Params& P, int g, int mt, int nt, u16* smem) {
    const u16* XS = (const u16*)(P.ws + OFF_XS);
    const u16* KU = (const u16*)(P.ws + OFF_KUNIQ) + (size_t)g * 64 * 256;
    const u16* WCT = (const u16*)(P.ws + OFF_WCT) + ((size_t)g * 1024 + nt * 128) * 128;
    const u16* HIN = (const u16*)(P.ws + OFF_HIN) + ((size_t)g * 256 + mt * 128) * 128;
    const int nkT = 2 * nt + 2;
    const int m0 = mt * 128;
    f32x16 acc[2][2];
    zero_acc<2>(acc);
    gemm_mainloop<2>(acc, nkT + 2,
        [=](int r, int ks, int c) {
            if (ks < nkT) return ldg16(XS + ((size_t)(g * 256 + m0 + r)) * 1024 + ks * 64 + c * 8);
            return ldg16(HIN + (size_t)r * 128 + (ks - nkT) * 64 + c * 8); },
        [=](int r, int ks, int c) {
            if (ks < nkT) { const int ng = nt * 128 + r, t = ng >> 4, ho = ng & 15, s = ks * 4 + (c >> 1), lag = t - s;
                            return ldg16(KU + ((lag < 0 ? 0 : lag) * 16 + ho) * 16 + (c & 1) * 8); }
            return ldg16(WCT + (size_t)r * 128 + (ks - nkT) * 64 + c * 8); },
        smem, smem + 128 * LDT,
        [=](int r, int ks, int c, u32x4 v) { const int t = (nt * 128 + r) >> 4, s = ks * 4 + (c >> 1); return (ks < nkT && s > t) ? zero4() : v; });
    u16* YS = (u16*)(P.ws + OFF_K);
    const int lane = VTID & 63, w = VTID >> 6, wr = w >> 1, wc = w & 1, hf = lane >> 5;
#pragma unroll
    for (int mi = 0; mi < 2; ++mi)
#pragma unroll
        for (int ni = 0; ni < 2; ++ni) {
            const int ng = nt * 128 + wc * 64 + ni * 32 + (lane & 31), t = ng >> 4, ho = ng & 15;
#pragma unroll
            for (int i = 0; i < 16; ++i) {
                const int m = m0 + wr * 64 + mi * 32 + (i & 3) + 8 * (i >> 2) + 4 * hf;
                const size_t tok = (size_t)(m >> 5) * 2048 + (m & 31) * 64 + t;
                YS[tok * 512 + g * 16 + ho] = f2bf(gelu_tanh(acc[mi][ni][i]));
            }
        }
}

DI void ph_ln(const Params& P, int row) {
    const int lane = tidx() & 63;
    float* o = P.out + (size_t)row * 1024;
    f32x4 xv[4];
#pragma unroll
    for (int c = 0; c < 4; ++c) xv[c] = *(const f32x4*)&o[c * 256 + lane * 4];
    float s = 0.f;
#pragma unroll
    for (int c = 0; c < 4; ++c) s += (xv[c][0] + xv[c][1]) + (xv[c][2] + xv[c][3]);
    const float mu = wave_sum(s) * (1.f / 1024.f);
    float v = 0.f;
#pragma unroll
    for (int c = 0; c < 4; ++c)
#pragma unroll
        for (int i = 0; i < 4; ++i) { const float d = xv[c][i] - mu; v += d * d; }
    const float rstd = 1.f / sqrtf(wave_sum(v) * (1.f / 1024.f) + LN_EPS);
#pragma unroll
    for (int c = 0; c < 4; ++c) {
        const f32x4 g = *(const f32x4*)&P.ln_g[c * 256 + lane * 4], bb = *(const f32x4*)&P.ln_b[c * 256 + lane * 4];
        f32x4 r;
#pragma unroll
        for (int i = 0; i < 4; ++i) r[i] = (xv[c][i] - mu) * rstd * g[i] + bb[i];
        *(f32x4*)&o[c * 256 + lane * 4] = r;
    }
}

namespace pg8 {
#define PG8_LAS __attribute__((address_space(3)))
typedef unsigned short bf16_t;
typedef short bf16x8 __attribute__((ext_vector_type(8)));
typedef float f32x4 __attribute__((ext_vector_type(4)));
typedef unsigned u32x4 __attribute__((ext_vector_type(4)));
constexpr int BM = 256, BK = 64, HALF = 128, HTB = HALF * BK * 2  , STAGE_BYTES = 8 * HTB, NXCD = 8, WGM = 8;

__host__ __device__ __forceinline__ int lds_byte(int r, int c) { const int st = (r >> 4) * 2 + (c >> 5), rr = r & 15, cc = c & 31, ob = rr * 64 + cc * 2; return st * 1024 + (ob ^ (((ob >> 9) & 1) << 5)); }
__host__ __device__ __forceinline__ void stage_rc(int b, int& R, int& C) { const int st = b / 1024, sb = b % 1024, swz = sb ^ (((sb >> 9) & 1) << 5); R = (st >> 1) * 16 + swz / 64; C = (st & 1) * 32 + (swz % 64) / 2; }
__host__ __device__ __forceinline__ int perm32(int rho) { const int n = rho >> 4, i = rho & 15; return 8 * (i >> 2) + 4 * n + (i & 3); }

struct Unit { int pm, pn; };
struct Gemm { const bf16_t* A; const bf16_t* Bt; int M, N, K; };

struct StaticOrder {
    int nM, nN, nwg, G, c;
    __host__ __device__ void init(int M, int N, int G_, int c_) { nM = M / BM; nN = N / BM; nwg = nM * nN; G = G_; c = c_; }
    __host__ __device__ bool next(int i, Unit& u) const {
        const long L = (long)i * G + c; if (L >= nwg) return false;
        int wgid = (int)L; { const int q = nwg / NXCD, r = nwg % NXCD, xcd = wgid % NXCD, off = wgid / NXCD; wgid = (xcd < r ? xcd * (q + 1) : r * (q + 1) + (xcd - r) * q) + off; }
        const int nig = WGM * nN, gid = wgid / nig, fm = gid * WGM, gsz = (nM - fm) < WGM ? (nM - fm) : WGM;
        u.pm = fm + ((wgid % nig) % gsz); u.pn = (wgid % nig) / gsz; return true;
    }
    __device__ __forceinline__ void a_ready(const Unit&) const {}
    __device__ __forceinline__ void done(const Unit&) const {}
};
template <class Epi, class Sched, bool STAMP = false>
__device__ __forceinline__ void gemm_phase(PG8_LAS unsigned char* lds, const Gemm g, const Sched& S, const Epi& E, unsigned long long* stamps) {
    const int tid = threadIdx.x, wid = __builtin_amdgcn_readfirstlane(tid >> 6), lane = tid & 63, wr = wid >> 2, wc = wid & 3, fr = lane & 15, fq = lane >> 4;
    const int K = g.K, nt = K / BK;
    int ts_lo = 0, ts_hi = 0, nts = 0; const unsigned long long rt_entry = STAMP ? (unsigned long long)wall_clock64() : 0ull;
#define PG8_STAMP() do { if (STAMP && wid == 0 && nts < 64) { const unsigned long long _c = (unsigned long long)clock64(); \
        ts_lo = (lane == nts) ? (int)(unsigned)_c : ts_lo; ts_hi = (lane == nts) ? (int)(unsigned)(_c >> 32) : ts_hi; ++nts; } } while (0)
    PG8_STAMP();
    unsigned voffA[2], voffB[2];
#pragma unroll
    for (int i = 0; i < 2; ++i) { int R, C; stage_rc(tid * 16 + i * 8192, R, C); const int Rb = Epi::PERM ? ((R & ~31) + perm32(R & 31)) : R;
        voffA[i] = (unsigned)(R * K + C) * 2u; voffB[i] = (unsigned)(Rb * K + C) * 2u; }
    const size_t kstep = (size_t)(BK * 2);
    const size_t hstep = (size_t)HALF * K * 2;
    const size_t tstep = 2 * hstep;
    const unsigned ldsw = (unsigned)wid * 1024u;
    const int aoff = lds_byte(wr * 64 + fr, fq * 8), boff = lds_byte(wc * 32 + fr, fq * 8);
#define PG8_SA(b, h) (((b) * 2 + (h)) * HTB)
#define PG8_SB(b, h) ((4 + (b) * 2 + (h)) * HTB)
#define PG8_STAGE(bufoff, gbase, voff) do { _Pragma("unroll") for (int _i = 0; _i < 2; ++_i) \
        __builtin_amdgcn_global_load_lds((const unsigned*)((const char*)(gbase) + (voff)[_i]), (PG8_LAS unsigned*)(lds + (bufoff) + ldsw + _i * 8192), 16, 0, 0); } while (0)
#define PG8_LDA(dst, b, h) do { _Pragma("unroll") for (int m = 0; m < 4; ++m) _Pragma("unroll") for (int k = 0; k < 2; ++k) dst[m][k] = *(const PG8_LAS bf16x8*)(lds + PG8_SA(b, h) + aoff + m * 2048 + k * 1024); } while (0)
#define PG8_LDB(dst, b, h) do { _Pragma("unroll") for (int n = 0; n < 2; ++n) _Pragma("unroll") for (int k = 0; k < 2; ++k) dst[n][k] = *(const PG8_LAS bf16x8*)(lds + PG8_SB(b, h) + boff + n * 2048 + k * 1024); } while (0)
#define PG8_MMA(ai, bj, At, Bt) do { __builtin_amdgcn_s_setprio(1); _Pragma("unroll") for (int m = 0; m < 4; ++m) _Pragma("unroll") for (int n = 0; n < 2; ++n) _Pragma("unroll") for (int k = 0; k < 2; ++k) \
        acc[ai][bj][m][n] = __builtin_amdgcn_mfma_f32_16x16x32_bf16(Bt[n][k], At[m][k], acc[ai][bj][m][n], 0, 0, 0); __builtin_amdgcn_s_setprio(0); } while (0)
#define PG8_WAIT_V(n) asm volatile("s_waitcnt vmcnt(" #n ")" ::: "memory")
#define PG8_WAIT_L(n) asm volatile("s_waitcnt lgkmcnt(" #n ")" ::: "memory")
#define PG8_BAR __builtin_amdgcn_s_barrier()
#define PG8_SCHED __builtin_amdgcn_sched_barrier(0)
    Unit cur, nxt; int ui = 0;
    if (!S.next(0, cur)) return;
    f32x4 acc[2][2][4][2];
#pragma unroll
    for (int a = 0; a < 2; ++a)
#pragma unroll
        for (int b = 0; b < 2; ++b)
#pragma unroll
            for (int m = 0; m < 4; ++m)
#pragma unroll
                for (int n = 0; n < 2; ++n) acc[a][b][m][n] = (f32x4){0.f, 0.f, 0.f, 0.f};
    bf16x8 At[4][2], B0[2][2], B1[2][2];
    const char* cA = (const char*)g.A + (size_t)cur.pm * tstep; const char* cB = (const char*)g.Bt + (size_t)cur.pn * tstep;
    S.a_ready(cur);
    PG8_STAGE(PG8_SB(0, 0), cB, voffB); PG8_STAGE(PG8_SA(0, 0), cA, voffA); PG8_STAGE(PG8_SB(0, 1), cB + hstep, voffB); PG8_STAGE(PG8_SA(0, 1), cA + hstep, voffA);
    if (wr == 1) PG8_BAR;
    PG8_WAIT_V(4); PG8_BAR;
    PG8_STAGE(PG8_SB(1, 0), cB + kstep, voffB); PG8_STAGE(PG8_SA(1, 0), cA + kstep, voffA); PG8_STAGE(PG8_SB(1, 1), cB + hstep + kstep, voffB);
    PG8_WAIT_V(6); PG8_BAR;
    PG8_STAMP();
    for (;;) {
        const bool has_next = S.next(ui + 1, nxt);
        const char* nA = has_next ? (const char*)g.A + (size_t)nxt.pm * tstep : cA; const char* nB = has_next ? (const char*)g.Bt + (size_t)nxt.pn * tstep : cB;
        for (int t = 0; t < nt; t += 2) {
            const bool last = (t == nt - 2);
            if constexpr (Epi::MID) { if (t == (nt >> 1)) E.mid(acc, cur, wr, wc, fr, fq); }
            const char* a1 = cA + (size_t)(t + 1) * kstep;
            const char* a2 = last ? nA : cA + (size_t)(t + 2) * kstep; const char* b2 = last ? nB : cB + (size_t)(t + 2) * kstep;
            const char* a3 = a2 + kstep; const char* b3 = b2 + kstep;
            if (last && has_next) S.a_ready(nxt);
            PG8_LDB(B0, 0, 0); PG8_SCHED; PG8_LDA(At, 0, 0); PG8_STAGE(PG8_SA(1, 1), a1 + hstep, voffA);
            PG8_WAIT_L(8); PG8_BAR; PG8_WAIT_L(0); PG8_MMA(0, 0, At, B0); PG8_BAR; PG8_SCHED;
            PG8_LDB(B1, 0, 1); PG8_STAGE(PG8_SB(0, 0), b2, voffB);
            PG8_BAR; PG8_WAIT_L(0); PG8_MMA(0, 1, At, B1); PG8_BAR;
            PG8_LDA(At, 0, 1); PG8_STAGE(PG8_SA(0, 0), a2, voffA);
            PG8_BAR; PG8_WAIT_L(0); PG8_MMA(1, 0, At, B0); PG8_BAR; PG8_SCHED;
            PG8_STAGE(PG8_SB(0, 1), b2 + hstep, voffB);
            PG8_WAIT_V(6); PG8_BAR; PG8_MMA(1, 1, At, B1); PG8_BAR;
            PG8_LDB(B0, 1, 0); PG8_SCHED; PG8_LDA(At, 1, 0); PG8_STAGE(PG8_SA(0, 1), a2 + hstep, voffA);
            PG8_WAIT_L(8); PG8_BAR; PG8_WAIT_L(0); PG8_MMA(0, 0, At, B0); PG8_BAR; PG8_SCHED;
            PG8_LDB(B1, 1, 1); PG8_STAGE(PG8_SB(1, 0), b3, voffB);
            PG8_BAR; PG8_WAIT_L(0); PG8_MMA(0, 1, At, B1); PG8_BAR;
            PG8_LDA(At, 1, 1); PG8_STAGE(PG8_SA(1, 0), a3, voffA);
            PG8_BAR; PG8_WAIT_L(0); PG8_MMA(1, 0, At, B0); PG8_BAR; PG8_SCHED;
            PG8_STAGE(PG8_SB(1, 1), b3 + hstep, voffB);
            PG8_WAIT_V(6); PG8_BAR; PG8_MMA(1, 1, At, B1); PG8_BAR;
        }
        PG8_STAMP();
        if constexpr (!Epi::AFTER_DRAIN) { E(acc, cur, wr, wc, fr, fq); S.done(cur); }
        PG8_STAMP();
        if (!has_next) break;
#pragma unroll
        for (int a = 0; a < 2; ++a)
#pragma unroll
            for (int b = 0; b < 2; ++b)
#pragma unroll
                for (int m = 0; m < 4; ++m)
#pragma unroll
                    for (int n = 0; n < 2; ++n) acc[a][b][m][n] = (f32x4){0.f, 0.f, 0.f, 0.f};
        cur = nxt; cA = nA; cB = nB; ++ui;
    }
    PG8_WAIT_V(0);
    if (wr == 0) PG8_BAR;
    PG8_BAR;
    if constexpr (Epi::AFTER_DRAIN) { E.fused(acc, cur, wr, wc, fr, fq, lds, wid, lane); S.done(cur); }
    PG8_STAMP();
    if (STAMP && wid == 0) { stamps[lane] = lane < nts ? (((unsigned long long)(unsigned)ts_hi << 32) | (unsigned)ts_lo) : 0ull;
        if (lane == 62) stamps[62] = rt_entry; if (lane == 63) stamps[63] = (unsigned long long)wall_clock64(); }
#undef PG8_STAMP
#undef PG8_SA
#undef PG8_SB
#undef PG8_STAGE
#undef PG8_LDA
#undef PG8_LDB
#undef PG8_MMA
#undef PG8_WAIT_V
#undef PG8_WAIT_L
#undef PG8_BAR
#undef PG8_SCHED
}
}

typedef pg8::f32x4 pf4;
struct EpiProj {
    static constexpr bool PERM = true, AFTER_DRAIN = false, MID = false;
    unsigned char* ws;
    DI void operator()(const pf4 (&acc)[2][2][4][2], const pg8::Unit& u, int wr, int wc, int fr, int fq) const {
        const int pn = u.pn; u16* base; int ld, cb, act;
        if (pn < 10) { const int seg = pn >> 1; base = (u16*)(ws + (seg == 0 ? OFF_XS : seg == 1 ? OFF_ZS : seg == 2 ? OFF_Q : seg == 3 ? OFF_K : OFF_ZA)); ld = 512; cb = (pn & 1) * 256; act = (seg == 1 || seg == 4) ? 1 : 0; }
        else if (pn < 14) { base = (u16*)(ws + OFF_GS); ld = 1024; cb = (pn - 10) * 256; act = 2; }
        else { base = (u16*)(ws + OFF_GA); ld = 1024; cb = (pn - 14) * 256; act = 2; }
        const int row0 = u.pm * 256 + wr * 64 + fr, col0 = cb + wc * 32 + 8 * fq;
        if (pn < 2) {
#pragma unroll
            for (int ai = 0; ai < 2; ++ai)
#pragma unroll
                for (int m = 0; m < 4; ++m) {
                    const int r = row0 + ai * 128 + m * 16, bc = r >> 6, sl = r & 63;
#pragma unroll
                    for (int bj = 0; bj < 2; ++bj) {
                        const int ch = col0 + bj * 128, g = ch >> 4, hi0 = ch & 15;
                        const pf4 a = acc[ai][bj][m][0], b4 = acc[ai][bj][m][1];
                        u32x4 w = {pk2(a[0], a[1]), pk2(a[2], a[3]), pk2(b4[0], b4[1]), pk2(b4[2], b4[3])};
                        *(u32x4*)(base + ((size_t)(g * 256 + bc)) * 1024 + sl * 16 + hi0) = w;
                    }
                }
            return;
        }
        if (pn == 4 || pn == 5) act = 3;
#pragma unroll
        for (int ai = 0; ai < 2; ++ai)
#pragma unroll
            for (int m = 0; m < 4; ++m) {
                u16* rowp = base + (size_t)(row0 + ai * 128 + m * 16) * ld + col0;
#pragma unroll
                for (int bj = 0; bj < 2; ++bj) {
                    float v[8];
#pragma unroll
                    for (int j = 0; j < 4; ++j) { v[j] = acc[ai][bj][m][0][j]; v[4 + j] = acc[ai][bj][m][1][j]; }
                    if (act == 3) {
#pragma unroll
                        for (int j = 0; j < 8; ++j) v[j] *= (0.125f * LOG2E);
                    } else if (act == 1) {
#pragma unroll
                        for (int j = 0; j < 8; ++j) v[j] = siluf_(v[j]);
                    } else if (act == 2) {
#pragma unroll
                        for (int j = 0; j < 8; ++j) v[j] = sigmoidf_(v[j]);
                    }
                    u32x4 w = {pk2(v[0], v[1]), pk2(v[2], v[3]), pk2(v[4], v[5]), pk2(v[6], v[7])};
                    *(u32x4*)(rowp + bj * 128) = w;
                }
            }
    }
};
struct EpiPlain {
    static constexpr bool PERM = true, AFTER_DRAIN = false, MID = false;
    u16* C; int ld;
    DI void operator()(const pf4 (&acc)[2][2][4][2], const pg8::Unit& u, int wr, int wc, int fr, int fq) const {
        const int row0 = u.pm * 256 + wr * 64 + fr, col0 = u.pn * 256 + wc * 32 + 8 * fq;
#pragma unroll
        for (int ai = 0; ai < 2; ++ai)
#pragma unroll
            for (int m = 0; m < 4; ++m) {
                u16* rowp = C + (size_t)(row0 + ai * 128 + m * 16) * ld + col0;
#pragma unroll
                for (int bj = 0; bj < 2; ++bj) {
                    const pf4 a = acc[ai][bj][m][0], b = acc[ai][bj][m][1];
                    u32x4 w = {pk2(a[0], a[1]), pk2(a[2], a[3]), pk2(b[0], b[1]), pk2(b[2], b[3])};
                    *(u32x4*)(rowp + bj * 128) = w;
                }
            }
    }
};
struct EpiGlu {
    static constexpr bool PERM = true, AFTER_DRAIN = false, MID = false;
    const u16* ZS; u16* AS;
    DI void operator()(const pf4 (&acc)[2][2][4][2], const pg8::Unit& u, int wr, int wc, int fr, int fq) const {
        const int row0 = u.pm * 256 + wr * 64 + fr, ch0 = u.pn * 128 + wc * 32 + 8 * fq;
#pragma unroll
        for (int ai = 0; ai < 2; ++ai)
#pragma unroll
            for (int m = 0; m < 4; ++m) {
                const size_t off = (size_t)(row0 + ai * 128 + m * 16) * 512 + ch0;
                const size_t offo = (size_t)(row0 + ai * 128 + m * 16) * 1024 + ch0;
                const u32x4 z = *(const u32x4*)(ZS + off);
                float o[8];
#pragma unroll
                for (int j = 0; j < 4; ++j) {
                    o[j] = acc[ai][0][m][0][j] * sigmoidf_(acc[ai][1][m][0][j]);
                    o[4 + j] = acc[ai][0][m][1][j] * sigmoidf_(acc[ai][1][m][1][j]);
                }
                u32x4 w = {pk2(o[0] * bflo(z[0]), o[1] * bfhi(z[0])), pk2(o[2] * bflo(z[1]), o[3] * bfhi(z[1])),
                           pk2(o[4] * bflo(z[2]), o[5] * bfhi(z[2])), pk2(o[6] * bflo(z[3]), o[7] * bfhi(z[3]))};
                *(u32x4*)(AS + offo) = w;
            }
    }
};
struct EpiMerge {
    static constexpr bool PERM = true, AFTER_DRAIN = false, MID = true;
    const u16* GS; const u16* GA; u16* MG;
    DI void mid(pf4 (&acc)[2][2][4][2], const pg8::Unit& u, int, int, int, int) const {
        const int t_ = tidx(), wid = t_ >> 6, lane = t_ & 63, wr = wid >> 2, wc = wid & 3, fr = lane & 15, fq = lane >> 4;
        const int row0 = u.pm * 256 + wr * 64 + fr, col0 = u.pn * 256 + wc * 32 + 8 * fq;
#pragma unroll
        for (int ai = 0; ai < 2; ++ai)
#pragma unroll
            for (int m = 0; m < 4; ++m) {
#pragma unroll
                for (int bj = 0; bj < 2; ++bj) {
                    const size_t off = (size_t)(row0 + ai * 128 + m * 16) * 1024 + col0 + bj * 128;
                    const u32x4 s4 = *(const u32x4*)(GS + off), a4 = *(const u32x4*)(GA + off);
#pragma unroll
                    for (int j = 0; j < 4; ++j) {
                        const float sl = bflo(s4[j]), sh = bfhi(s4[j]), al = fmaxf(bflo(a4[j]), 1e-30f), ah = fmaxf(bfhi(a4[j]), 1e-30f);
                        acc[ai][bj][m][j >> 1][(j & 1) * 2] *= sl * __builtin_amdgcn_rcpf(al);
                        acc[ai][bj][m][j >> 1][(j & 1) * 2 + 1] *= sh * __builtin_amdgcn_rcpf(ah);
                    }
                }
                asm volatile("" ::: "memory");
            }
    }
    DI void operator()(const pf4 (&acc)[2][2][4][2], const pg8::Unit& u, int wr, int wc, int fr, int fq) const {
        const int row0 = u.pm * 256 + wr * 64 + fr, col0 = u.pn * 256 + wc * 32 + 8 * fq;
#pragma unroll
        for (int ai = 0; ai < 2; ++ai)
#pragma unroll
            for (int m = 0; m < 4; ++m)
#pragma unroll
                for (int bj = 0; bj < 2; ++bj) {
                    const size_t off = (size_t)(row0 + ai * 128 + m * 16) * 1024 + col0 + bj * 128;
                    const u32x4 a4 = *(const u32x4*)(GA + off);
                    const pf4 x = acc[ai][bj][m][0], y = acc[ai][bj][m][1];
                    u32x4 w = {pk2(x[0] * bflo(a4[0]), x[1] * bfhi(a4[0])), pk2(x[2] * bflo(a4[1]), x[3] * bfhi(a4[1])),
                               pk2(y[0] * bflo(a4[2]), y[1] * bfhi(a4[2])), pk2(y[2] * bflo(a4[3]), y[3] * bfhi(a4[3]))};
                    *(u32x4*)(MG + off) = w;
                }
    }
};
struct EpiOut {
    static constexpr bool PERM = false, AFTER_DRAIN = false, MID = false;
    const float* X; const float* MOD; float* O;
    DI void operator()(const pf4 (&acc)[2][2][4][2], const pg8::Unit& u, int wr, int wc, int fr, int fq) const {
        const int row0 = u.pm * 256 + wr * 64 + fr, col0 = u.pn * 256 + wc * 32 + 4 * fq;
        const float* gate = MOD + (u.pm >> 3) * 3072 + 2048;
#pragma unroll
        for (int bj = 0; bj < 2; ++bj)
#pragma unroll
            for (int n = 0; n < 2; ++n) {
                const pf4 gt = *(const pf4*)(gate + col0 + bj * 128 + n * 16);
#pragma unroll
                for (int ai = 0; ai < 2; ++ai)
#pragma unroll
                    for (int m = 0; m < 4; ++m) {
                        const size_t off = (size_t)(row0 + ai * 128 + m * 16) * 1024 + col0 + bj * 128 + n * 16;
                        const pf4 x = *(const pf4*)(X + off);
                        const pf4 a = acc[ai][bj][m][n];
                        pf4 o = {DN_ALPHA * x[0] + a[0] * gt[0], DN_ALPHA * x[1] + a[1] * gt[1], DN_ALPHA * x[2] + a[2] * gt[2], DN_ALPHA * x[3] + a[3] * gt[3]};
                        *(pf4*)(O + off) = o;
                    }
            }
    }
};

constexpr int VB_LDS = 49152;
constexpr int LDS_BYTES = 131072 + 64;
__global__ void __launch_bounds__(512, 2) fwd_megakernel(Params P) {
    extern __shared__ __attribute__((aligned(16))) unsigned char lds_raw[];
    const int tid = threadIdx.x, bid = blockIdx.x, nb = gridDim.x;
    const int nv = nb * 2;
#define VB (tidx() >> 8)
    volatile unsigned* st = (volatile unsigned*)(lds_raw + 131072);
    if (tid < 4) st[tid] = 0u;
    __syncthreads();
    XcdBarrier bar; bar.bar = (unsigned*)(P.ws + OFF_BAR); bar.x = xb_xcc_id(); bar.st = st;
    if (tid == 0) (void)xb_add(&bar.bar[XB_XCNT(bar.x)], 1u);
    PG8_LAS unsigned char* stage = (PG8_LAS unsigned char*)lds_raw;
    unsigned char* ws = P.ws;

    {
        const int vb = VB, v = bid * 2 + vb;
        float* sa = (float*)(lds_raw + 32768 + vb * VB_LDS);
        for (int it = v; it < 768 + 96; it += nv) {
            if (it < 768) { const int part = it % 3, gj = it / 3; pa_s5(P, gj >> 3, gj & 7, part, sa); }
            else pa_mod(P, it - 768, sa);
        }
    }
    xcd_barrier(bar);
    {
        const int vb = VB, v = bid * 2 + vb;
        float* sWf = (float*)lds_raw;
        u16* sa = (u16*)(lds_raw + 32768 + vb * VB_LDS);
        for (int i = tidx(); i < 8192; i += 512) { const int k = i >> 3, h = i & 7; sWf[h * 1024 + k] = P.w_in[(size_t)k * INCOLS + 2560 + h]; }
        __syncthreads();
        for (int it = v; it < 512 + 1920; it += nv) {
            if (it < 512) { pa2_rows(P, it, sWf); continue; }
            int t = it - 512;
            if (t < 1280) pa_transpose(P.w_in, INCOLS, 1024, (u16*)(ws + OFF_WINT), 0, t / 80, t % 80, sa);
            else if ((t -= 1280) < 128) pa_transpose(P.w_glu, 1024, 512, (u16*)(ws + OFF_WGLUT), 1, t >> 4, t & 15, sa);
            else if ((t -= 128) < 128) pa_transpose(P.w_ps, 1024, 1024, (u16*)(ws + OFF_WPST), 2, t >> 4, t & 15, sa);
            else if ((t -= 128) < 128) pa_transpose(P.w_pa, 1024, 1024, (u16*)(ws + OFF_WPST) + 512, 2, t >> 4, t & 15, sa);
            else { t -= 128; pa_transpose(P.w_out, 1024, 1024, (u16*)(ws + OFF_WOUTT), 2, t >> 4, t & 15, sa); }
        }
    }
    xcd_barrier(bar);
    { const int vb = VB, v = bid * 2 + vb; for (int it = v; it < 64; it += nv) pb_cumsum(P, it, (float*)(lds_raw + vb * VB_LDS)); }
    __syncthreads();
    {
        pg8::Gemm g; g.A = (const u16*)(ws + OFF_U); g.Bt = (const u16*)(ws + OFF_WINT); g.M = NTOK; g.N = 4608; g.K = 1024;
        pg8::StaticOrder S; S.init(g.M, g.N, nb, bid);
        EpiProj E; E.ws = ws;
        pg8::gemm_phase<EpiProj, pg8::StaticOrder, false>(stage, g, S, E, nullptr);
    }
    {
        pg8::Gemm g; g.A = (const u16*)(ws + OFF_WINT) + (size_t)4608 * 1024; g.Bt = (const u16*)(ws + OFF_U); g.M = 512; g.N = NTOK; g.K = 1024;
        pg8::StaticOrder S; S.init(g.M, g.N, nb, (bid + 128) % nb);
        EpiPlain E; E.C = (u16*)(ws + OFF_VT); E.ld = NTOK;
        pg8::gemm_phase<EpiPlain, pg8::StaticOrder, false>(stage, g, S, E, nullptr);
    }
    xcd_barrier(bar);
    __syncthreads();
    for (int it = bid; it < 256; it += nb) pc_s5a2(P, it >> 3, it & 7, (float*)lds_raw);
    {
        for (int it = bid; it < 256; it += nb) {
            const int xi = it >> 3, bh = (it & 7) * 8 + (xi >> 2), j = xi & 3;
            pc_attn3(P, bh >> 3, bh & 7, 7 - j, lds_raw);
            pc_attn3(P, bh >> 3, bh & 7, j, lds_raw);
        }
    }
    xcd_barrier(bar);
    { const int vb = VB, v = bid * 2 + vb; u16* smem = (u16*)(lds_raw + vb * VB_LDS); for (int it = v; it < 512; it += nv) { const int nt = 7 - (it >> 6), r = it & 63; pd_s5b(P, r >> 1, r & 1, nt, smem); } }
    xcd_barrier(bar);
    {
        pg8::Gemm g; g.A = (const u16*)(ws + OFF_K); g.Bt = (const u16*)(ws + OFF_WGLUT); g.M = NTOK; g.N = 1024; g.K = 512;
        pg8::StaticOrder S; S.init(g.M, g.N, nb, bid);
        EpiGlu E; E.ZS = (const u16*)(ws + OFF_ZS); E.AS = (u16*)(ws + OFF_AB);
        pg8::gemm_phase<EpiGlu, pg8::StaticOrder, false>(stage, g, S, E, nullptr);
    }
    xcd_barrier(bar);
    {
        pg8::Gemm g; g.A = (const u16*)(ws + OFF_AB); g.Bt = (const u16*)(ws + OFF_WPST); g.M = NTOK; g.N = 1024; g.K = 1024;
        pg8::StaticOrder S; S.init(g.M, g.N, nb, bid);
        EpiMerge E; E.GS = (const u16*)(ws + OFF_GS); E.GA = (const u16*)(ws + OFF_GA); E.MG = (u16*)(ws + OFF_MG);
        pg8::gemm_phase<EpiMerge, pg8::StaticOrder, false>(stage, g, S, E, nullptr);
    }
    xcd_barrier(bar);
    {
        pg8::Gemm g; g.A = (const u16*)(ws + OFF_MG); g.Bt = (const u16*)(ws + OFF_WOUTT); g.M = NTOK; g.N = 1024; g.K = 1024;
        pg8::StaticOrder S; S.init(g.M, g.N, nb, bid);
        EpiOut E; E.X = P.x; E.MOD = (const float*)(ws + OFF_MOD); E.O = P.out;
        pg8::gemm_phase<EpiOut, pg8::StaticOrder, false>(stage, g, S, E, nullptr);
    }
    xcd_barrier(bar);
    for (int row = bid * 8 + (tidx() >> 6); row < NTOK; row += nb * 8) ph_ln(P, row);
}

extern "C" void kernel_launch(void* const* d_in, const int* in_sizes, int n_in, void* d_out, int out_size, void* d_ws, size_t ws_size, hipStream_t stream) {
    static int grid = 0;
    if (grid == 0) {
        if (ws_size < WS_END) { fprintf(stderr, "kernel_launch: workspace too small: %zu < %zu\n", ws_size, (size_t)WS_END); grid = -1; return; }
        int dev = 0, cus = 0, per_cu = 0;
        (void)hipGetDevice(&dev);
        (void)hipDeviceGetAttribute(&cus, hipDeviceAttributeMultiprocessorCount, dev);
        if (hipFuncSetAttribute((const void*)fwd_megakernel, hipFuncAttributeMaxDynamicSharedMemorySize, LDS_BYTES) != hipSuccess) { fprintf(stderr, "kernel_launch: hipFuncSetAttribute failed\n"); grid = -1; return; }
        (void)hipOccupancyMaxActiveBlocksPerMultiprocessor(&per_cu, (const void*)fwd_megakernel, 512, LDS_BYTES);
        if (per_cu < 1) { fprintf(stderr, "kernel_launch: occupancy query returned %d\n", per_cu); grid = -1; return; }
        grid = cus;
        if (grid != 256) fprintf(stderr, "kernel_launch: note: %d CUs (GEMM units are balanced for 256)\n", grid);
    }
    if (grid < 0) return;
    (void)hipMemsetAsync((char*)d_ws + OFF_BAR, 0, 16384, stream);
    Params p{};
    const float** pp = (const float**)&p;
    for (int i = 0; i < 20; ++i) pp[i] = (const float*)d_in[i];
    p.out = (float*)d_out; p.ws = (unsigned char*)d_ws;
    void* args[] = {&p};
    hipError_t e = hipLaunchCooperativeKernel((const void*)fwd_megakernel, dim3(grid), dim3(512), args, LDS_BYTES, stream);
    if (e != hipSuccess) fprintf(stderr, "cooperative launch failed: %s (grid %d)\n", hipGetErrorString(e), grid);
}
```

```cpp
#include <hip/hip_runtime.h>
#include <stdio.h>
#include <stdint.h>

#define DI __device__ __forceinline__
__device__ __forceinline__ int tidx() { int t = threadIdx.x; asm volatile("" : "+v"(t)); return t; }
#define VTID (tidx() & 255)
typedef unsigned short u16;
using bf16x8 = __attribute__((ext_vector_type(8))) short;
using f32x16 = __attribute__((ext_vector_type(16))) float;
using f32x4  = __attribute__((ext_vector_type(4))) float;
using u32x4  = __attribute__((ext_vector_type(4))) unsigned;
using u32x2  = __attribute__((ext_vector_type(2))) unsigned;
typedef __bf16 bf16x2_t __attribute__((ext_vector_type(2)));
typedef float f32x2_t __attribute__((ext_vector_type(2)));

#define MFMA(a, b, c) __builtin_amdgcn_mfma_f32_32x32x16_bf16((a), (b), (c), 0, 0, 0)

DI unsigned pk2(float lo, float hi) { f32x2_t v = {lo, hi}; return __builtin_bit_cast(unsigned, __builtin_convertvector(v, bf16x2_t)); }
DI u16 f2bf(float x) { return (u16)(pk2(x, 0.f) & 0xffffu); }
DI float bf2f(unsigned h) { return __uint_as_float(h << 16); }
DI float bflo(unsigned w) { return __uint_as_float(w << 16); }
DI float bfhi(unsigned w) { return __uint_as_float(w & 0xffff0000u); }
DI float sigmoidf_(float x) { return 1.f / (1.f + __expf(-x)); }
DI float siluf_(float x) { return x / (1.f + __expf(-x)); }

constexpr int NTOK = 16384, SEQ = 2048, DM = 1024, INCOLS = 5128;
constexpr float LN_EPS = 1e-5f;
constexpr float DN_ALPHA = 1.189207115002721f;
constexpr float LOG2E = 1.4426950408889634f;

constexpr size_t OFF_BAR   = 0;
constexpr size_t OFF_MOD   = 16384;
constexpr size_t OFF_APL   = OFF_MOD + 98304;
constexpr size_t OFF_LOGF  = OFF_APL + 16384;
constexpr size_t OFF_CUMF  = OFF_LOGF + 524288;
constexpr size_t OFF_KUNIQ = OFF_CUMF + 524288;
constexpr size_t OFF_WST   = OFF_KUNIQ + 1048576;
constexpr size_t OFF_WCT   = OFF_WST + 8388608;
constexpr size_t OFF_HIN   = OFF_WCT + 8388608;
constexpr size_t OFF_WINT  = OFF_HIN + 2097152;
constexpr size_t OFF_WGLUT = OFF_WINT + 10485760;
constexpr size_t OFF_WPST  = OFF_WGLUT + 1048576;
constexpr size_t OFF_WPAT  = OFF_WPST + 1048576;
constexpr size_t OFF_WOUTT = OFF_WPAT + 1048576;
constexpr size_t OFF_U     = OFF_WOUTT + 2097152;
constexpr size_t OFF_XS    = OFF_U + 33554432;
constexpr size_t OFF_ZS    = OFF_XS + 16777216;
constexpr size_t OFF_Q     = OFF_ZS + 16777216;
constexpr size_t OFF_K     = OFF_Q + 16777216;
constexpr size_t OFF_VT    = OFF_K + 16777216;
constexpr size_t OFF_ZA    = OFF_VT + 16777216;
constexpr size_t OFF_GS    = OFF_ZA + 16777216;
constexpr size_t OFF_GA    = OFF_GS + 33554432;
constexpr size_t WS_END    = OFF_GA + 33554432;
constexpr size_t OFF_AB = OFF_U;
constexpr size_t OFF_MG = OFF_XS;

struct Params {
    const float *x, *c, *w_ada, *b_ada, *w_in, *b_f, *lam_re, *lam_im, *log_dt, *b_re, *b_im, *c_re, *c_im, *ssm_d,
                *w_glu, *w_ps, *w_pa, *w_out, *ln_g, *ln_b;
    float* out;
    unsigned char* ws;
};

#define XB_TMO      128
#define XB_XCNT(j)  (256  + 64 * (j))
#define XB_XSUB(j)  (1280 + 64 * (j))
#define XB_XGEN(j)  (2304 + 64 * (j))
#define XB_TOP      3328
#define XB_TOPGEN   3392
#define XCD_BAR_WORDS 3456
#define XB_SPIN_CAP (1u << 22)

DI unsigned xb_ld(unsigned* p)              { return __hip_atomic_load(p, __ATOMIC_RELAXED, __HIP_MEMORY_SCOPE_AGENT); }
DI unsigned xb_add(unsigned* p, unsigned v) { return __hip_atomic_fetch_add(p, v, __ATOMIC_RELAXED, __HIP_MEMORY_SCOPE_AGENT); }
DI unsigned xb_xcc_id() { return (unsigned)__builtin_amdgcn_s_getreg((3 << 11) | 20) & 0xFu; }
#define XB_SPIN(cond, bar) do { unsigned _sp = 0; while (cond) { __builtin_amdgcn_s_sleep(1); \
    if ((++_sp & 255u) == 0u) { if (xb_ld(&(bar)[XB_TMO])) break; if (_sp > XB_SPIN_CAP) { atomicAdd(&(bar)[XB_TMO], 1u); break; } } } } while (0)

struct XcdBarrier { unsigned* bar; unsigned x; volatile unsigned* st; };

DI void xcd_barrier_complete(unsigned* bar, unsigned x, unsigned& nloc, unsigned& nx) {
    const unsigned G = gridDim.x;
    unsigned sum, cnt, mine, sp = 0u;
    for (;;) {
        sum = 0u; cnt = 0u; mine = 0u;
#pragma unroll
        for (unsigned j = 0; j < 16; ++j) { const unsigned c = xb_ld(&bar[XB_XCNT(j)]); sum += c; cnt += (c > 0u) ? 1u : 0u; mine = (j == x) ? c : mine; }
        if (sum == G) break;
        __builtin_amdgcn_s_sleep(1);
        if ((++sp & 255u) == 0u) { if (xb_ld(&bar[XB_TMO])) break; if (sp > XB_SPIN_CAP) { atomicAdd(&bar[XB_TMO], 1u); break; } }
    }
    nloc = mine > 0u ? mine : 1u; nx = cnt > 0u ? cnt : 1u;
}

DI void xcd_barrier(const XcdBarrier& b) {
    asm volatile("s_waitcnt vmcnt(0)" ::: "memory");
    __syncthreads();
    if (threadIdx.x == 0) {
        unsigned* bar = b.bar;
        __builtin_amdgcn_s_waitcnt(0);
        unsigned nloc = b.st[0], nx = b.st[1];
        if (nloc == 0u) { xcd_barrier_complete(bar, b.x, nloc, nx); b.st[0] = nloc; b.st[1] = nx; }
        const unsigned old = xb_add(&bar[XB_XSUB(b.x)], 1u);
        const unsigned gen = old / nloc;
        if (old + 1u == (gen + 1u) * nloc) {
            __builtin_amdgcn_fence(__ATOMIC_RELEASE, "agent");
            asm volatile("s_waitcnt vmcnt(0)" ::: "memory");
            const unsigned og = xb_add(&bar[XB_TOP], 1u);
            const unsigned tg = og / nx;
            if (og + 1u == (tg + 1u) * nx) xb_add(&bar[XB_TOPGEN], 1u);
            else XB_SPIN(xb_ld(&bar[XB_TOPGEN]) == tg, bar);
            __builtin_amdgcn_fence(__ATOMIC_ACQUIRE, "agent");
            xb_add(&bar[XB_XGEN(b.x)], 1u);
            asm volatile("s_waitcnt vmcnt(0)" ::: "memory");
        } else {
            XB_SPIN(xb_ld(&bar[XB_XGEN(b.x)]) == gen, bar);
            __builtin_amdgcn_fence(__ATOMIC_ACQUIRE, "agent");
            asm volatile("s_waitcnt vmcnt(0)" ::: "memory");
        }
    }
    __syncthreads();
}

DI float wave_sum(float v) {
#pragma unroll
    for (int o = 32; o > 0; o >>= 1) v += __shfl_xor(v, o, 64);
    return v;
}
DI u32x4 ldg16(const u16* p) { return *(const u32x4*)p; }
DI u32x4 zero4() { u32x4 z = {0u, 0u, 0u, 0u}; return z; }

constexpr int LDT = 72;
struct NoFix { DI u32x4 operator()(int, int, int, u32x4 v) const { return v; } };
template <int MT, class FA, class FB, class PB = NoFix>
DI void gemm_mainloop(f32x16 (&acc)[MT][2], int nk, FA fa, FB fb, u16* sA, u16* sB, PB pb = PB()) {
    const int tid = VTID, lane = tid & 63, w = tid >> 6, wr = w >> 1, wc = w & 1;
    const int cch = tid & 7, r0 = tid >> 3;
    u32x4 ra0[MT * 2], rb0[4], ra1[MT * 2], rb1[4];
#pragma unroll
    for (int i = 0; i < MT * 2; ++i) ra0[i] = fa(r0 + 32 * i, 0, cch);
#pragma unroll
    for (int i = 0; i < 4; ++i) rb0[i] = fb(r0 + 32 * i, 0, cch);
    if (nk > 1) {
#pragma unroll
        for (int i = 0; i < MT * 2; ++i) ra1[i] = fa(r0 + 32 * i, 1, cch);
#pragma unroll
        for (int i = 0; i < 4; ++i) rb1[i] = fb(r0 + 32 * i, 1, cch);
    }
#define GM_STEP(RA, RB, KS) do { \
        __syncthreads(); \
        _Pragma("unroll") for (int i = 0; i < MT * 2; ++i) *(u32x4*)&sA[(r0 + 32 * i) * LDT + cch * 8] = RA[i]; \
        _Pragma("unroll") for (int i = 0; i < 4; ++i) *(u32x4*)&sB[(r0 + 32 * i) * LDT + cch * 8] = pb(r0 + 32 * i, (KS), cch, RB[i]); \
        __syncthreads(); \
        if ((KS) + 2 < nk) { \
            _Pragma("unroll") for (int i = 0; i < MT * 2; ++i) RA[i] = fa(r0 + 32 * i, (KS) + 2, cch); \
            _Pragma("unroll") for (int i = 0; i < 4; ++i) RB[i] = fb(r0 + 32 * i, (KS) + 2, cch); \
        } \
        _Pragma("unroll") for (int kk = 0; kk < 4; ++kk) { \
            bf16x8 af[MT], bfr[2]; \
            _Pragma("unroll") for (int mi = 0; mi < MT; ++mi) af[mi] = *(const bf16x8*)&sA[(wr * 32 * MT + mi * 32 + (lane & 31)) * LDT + kk * 16 + (lane >> 5) * 8]; \
            _Pragma("unroll") for (int ni = 0; ni < 2; ++ni) bfr[ni] = *(const bf16x8*)&sB[(wc * 64 + ni * 32 + (lane & 31)) * LDT + kk * 16 + (lane >> 5) * 8]; \
            _Pragma("unroll") for (int mi = 0; mi < MT; ++mi) _Pragma("unroll") for (int ni = 0; ni < 2; ++ni) acc[mi][ni] = MFMA(af[mi], bfr[ni], acc[mi][ni]); \
        } } while (0)
    for (int ks = 0; ks < nk; ks += 2) {
        GM_STEP(ra0, rb0, ks);
        if (ks + 1 < nk) GM_STEP(ra1, rb1, ks + 1);
    }
#undef GM_STEP
}
template <int MT>
DI void zero_acc(f32x16 (&acc)[MT][2]) {
#pragma unroll
    for (int mi = 0; mi < MT; ++mi)
#pragma unroll
        for (int ni = 0; ni < 2; ++ni)
#pragma unroll
            for (int i = 0; i < 16; ++i) acc[mi][ni][i] = 0.f;
}

DI void pa_mod(const Params& P, int item, float* smem) {
    const int tid = VTID;
    float* sc = smem;
    float* red = smem + 8192;
    __syncthreads();
    for (int i = tid; i < 8192; i += 256) { const int b = i >> 10, k = i & 1023; sc[k * 8 + b] = siluf_(P.c[i]); }
    __syncthreads();
    const int nl = tid & 31, ks = tid >> 5, n = item * 32 + nl;
    float acc[8];
#pragma unroll
    for (int b = 0; b < 8; ++b) acc[b] = 0.f;
    for (int k = ks * 128; k < ks * 128 + 128; ++k) {
        const float wv = P.w_ada[(size_t)k * 3072 + n];
        const f32x4 s0 = *(const f32x4*)&sc[k * 8], s1 = *(const f32x4*)&sc[k * 8 + 4];
        acc[0] += s0[0] * wv; acc[1] += s0[1] * wv; acc[2] += s0[2] * wv; acc[3] += s0[3] * wv;
        acc[4] += s1[0] * wv; acc[5] += s1[1] * wv; acc[6] += s1[2] * wv; acc[7] += s1[3] * wv;
    }
#pragma unroll
    for (int b = 0; b < 8; ++b) red[(ks * 8 + b) * 32 + nl] = acc[b];
    __syncthreads();
    {
        const int b = tid >> 5;
        float s = P.b_ada[n];
#pragma unroll
        for (int k2 = 0; k2 < 8; ++k2) s += red[(k2 * 8 + b) * 32 + nl];
        ((float*)(P.ws + OFF_MOD))[b * 3072 + n] = s;
    }
}

DI int srccol(int mode, int n) {
    if (mode == 0) return n < 2048 ? n : (n < 4608 ? n + 520 : n - 2560);
    if (mode == 1) { const int pn = n >> 8, bj = (n >> 7) & 1, j = n & 127; return bj * 512 + pn * 128 + j; }
    return n;
}
DI void pa_transpose(const float* src, int ld, int K, u16* dst, int mode, int kt, int nt, u16* sT) {
    const int tid = VTID;
    __syncthreads();
    const int nl = tid & 63, kq = tid >> 6;
    const int sc = srccol(mode, nt * 64 + nl);
#pragma unroll
    for (int r = 0; r < 16; ++r) {
        const int k = r * 4 + kq;
        sT[k * 66 + nl] = f2bf(src[(size_t)(kt * 64 + k) * ld + sc]);
    }
    __syncthreads();
    const int n = tid >> 2, kc = (tid & 3) * 16;
    unsigned v[8];
#pragma unroll
    for (int j = 0; j < 8; ++j) v[j] = (unsigned)sT[(kc + 2 * j) * 66 + n] | ((unsigned)sT[(kc + 2 * j + 1) * 66 + n] << 16);
    u16* d = dst + (size_t)(nt * 64 + n) * K + kt * 64 + kc;
    u32x4 o0 = {v[0], v[1], v[2], v[3]}, o1 = {v[4], v[5], v[6], v[7]};
    *(u32x4*)d = o0; *(u32x4*)(d + 8) = o1;
}

DI void pa_s5(const Params& P, int g, int j, int part, float* smem) {
    const int tid = VTID;
    f32x2_t* sAp = (f32x2_t*)smem;
    f32x2_t* sBb = sAp + 64 * 9;
    f32x2_t* sC  = sBb + 64 * 16;
    f32x2_t* sCo = sC + 16 * 64;
    __syncthreads();
    const float dt = expf(P.log_dt[g]);
    if (tid < 64) {
        const float lr = P.lam_re[g * 64 + tid], li = P.lam_im[g * 64 + tid];
        const float th = li * dt, lm = lr * dt;
        double a = (double)th; a -= 6.283185307179586 * __builtin_rint(a * 0.15915494309189535);
        const float rr = (float)a, mag = expf(lm);
        const float abr = mag * cosf(rr), abi = mag * sinf(rr);
        const float den = lr * lr + li * li;
        f32x2_t co; co[0] = ((abr - 1.f) * lr + abi * li) / den; co[1] = (abi * lr - (abr - 1.f) * li) / den;
        sCo[tid] = co;
    }
    for (int i = tid; i < 576; i += 256) {
        const int p = i / 9, el = i % 9, e = 8 * j + el;
        const float lr = P.lam_re[g * 64 + p], li = P.lam_im[g * 64 + p];
        const float th = li * dt, lm = lr * dt;
        double a = (double)e * (double)th; a -= 6.283185307179586 * __builtin_rint(a * 0.15915494309189535);
        const float rr = (float)a, mag = expf((float)e * lm);
        f32x2_t v; v[0] = mag * cosf(rr); v[1] = mag * sinf(rr);
        sAp[p * 9 + el] = v;
    }
    __syncthreads();
    for (int i = tid; i < 1024; i += 256) {
        const int p = i >> 4, hi = i & 15;
        const float br = P.b_re[(g * 64 + p) * 16 + hi], bi = P.b_im[(g * 64 + p) * 16 + hi];
        const f32x2_t co = sCo[p];
        f32x2_t v; v[0] = co[0] * br - co[1] * bi; v[1] = co[0] * bi + co[1] * br;
        sBb[p * 16 + hi] = v;
        const int ho = i >> 6, p2 = i & 63;
        f32x2_t cv; cv[0] = P.c_re[(g * 16 + ho) * 64 + p2]; cv[1] = P.c_im[(g * 16 + ho) * 64 + p2];
        sC[ho * 64 + p2] = cv;
    }
    __syncthreads();
    if (part == 0) {
        const int ho = tid >> 4, hi = tid & 15;
        float acc[8];
#pragma unroll
        for (int l = 0; l < 8; ++l) acc[l] = 0.f;
        for (int p = 0; p < 64; ++p) {
            const f32x2_t cv = sC[ho * 64 + p], bb = sBb[p * 16 + hi];
            const float cbr = cv[0] * bb[0] - cv[1] * bb[1], cbi = cv[0] * bb[1] + cv[1] * bb[0];
#pragma unroll
            for (int l = 0; l < 8; ++l) { const f32x2_t ap = sAp[p * 9 + l]; acc[l] += cbr * ap[0] - cbi * ap[1]; }
        }
        if (j == 0 && ho == hi) acc[0] += P.ssm_d[g * 16 + ho];
        u16* ku = (u16*)(P.ws + OFF_KUNIQ);
#pragma unroll
        for (int l = 0; l < 8; ++l) ku[((g * 64 + 8 * j + l) * 16 + ho) * 16 + hi] = f2bf(acc[l]);
    }
    if (part == 1) {
        u16* wst = (u16*)(P.ws + OFF_WST);
        for (int idx = tid; idx < 16384; idx += 256) {
            const int hi = idx & 15, sl = (idx >> 4) & 7, n = idx >> 7, p = n >> 1, ri = n & 1;
            const f32x2_t ap = sAp[p * 9 + (7 - sl)], bb = sBb[p * 16 + hi];
            const float v = ri ? (ap[0] * bb[1] + ap[1] * bb[0]) : (ap[0] * bb[0] - ap[1] * bb[1]);
            wst[(size_t)(g * 128 + n) * 1024 + (56 - 8 * j + sl) * 16 + hi] = f2bf(v);
        }
    }
    if (part == 2) {
        u16* wct = (u16*)(P.ws + OFF_WCT);
        for (int idx = tid; idx < 16384; idx += 256) {
            const int k = idx & 127, ho = (idx >> 7) & 15, tl = idx >> 11, p = k >> 1, ri = k & 1;
            const f32x2_t ap = sAp[p * 9 + tl + 1], cv = sC[ho * 64 + p];
            const float v = ri ? -(cv[0] * ap[1] + cv[1] * ap[0]) : (cv[0] * ap[0] - cv[1] * ap[1]);
            wct[(size_t)(g * 1024 + (8 * j + tl) * 16 + ho) * 128 + k] = f2bf(v);
        }
    }
    if (part == 2 && j == 7 && tid < 64) ((f32x2_t*)(P.ws + OFF_APL))[g * 64 + tid] = sAp[tid * 9 + 8];
}

DI void pa2_rows(const Params& P, int item, const float* sWf) {
    const int tid = VTID, lane = tid & 63, w = tid >> 6;
    const int row0 = item * 32 + w * 8, b = row0 >> 11;
    const float* mod = (const float*)(P.ws + OFF_MOD) + b * 3072;
    f32x4 sh[4], sc[4];
#pragma unroll
    for (int c = 0; c < 4; ++c) {
        sh[c] = *(const f32x4*)&mod[c * 256 + lane * 4];
        sc[c] = *(const f32x4*)&mod[1024 + c * 256 + lane * 4];
    }
    u16* U = (u16*)(P.ws + OFF_U);
    float* logf = (float*)(P.ws + OFF_LOGF);
    f32x4 xn[4];
#pragma unroll
    for (int c = 0; c < 4; ++c) xn[c] = *(const f32x4*)&P.x[(size_t)row0 * 1024 + c * 256 + lane * 4];
    for (int r = 0; r < 8; ++r) {
        const int row = row0 + r;
        f32x4 xv[4];
#pragma unroll
        for (int c = 0; c < 4; ++c) xv[c] = xn[c];
        if (r + 1 < 8) {
#pragma unroll
            for (int c = 0; c < 4; ++c) xn[c] = *(const f32x4*)&P.x[(size_t)(row + 1) * 1024 + c * 256 + lane * 4];
        }
        float s = 0.f;
#pragma unroll
        for (int c = 0; c < 4; ++c) s += (xv[c][0] + xv[c][1]) + (xv[c][2] + xv[c][3]);
        const float mu = wave_sum(s) * (1.f / 1024.f);
        float v = 0.f;
#pragma unroll
        for (int c = 0; c < 4; ++c)
#pragma unroll
            for (int i = 0; i < 4; ++i) { const float d = xv[c][i] - mu; v += d * d; }
        const float rstd = 1.f / sqrtf(wave_sum(v) * (1.f / 1024.f) + LN_EPS);
        float part[8];
#pragma unroll
        for (int h = 0; h < 8; ++h) part[h] = 0.f;
#pragma unroll
        for (int c = 0; c < 4; ++c) {
            f32x4 u;
#pragma unroll
            for (int i = 0; i < 4; ++i) u[i] = (xv[c][i] - mu) * rstd * (1.f + sc[c][i]) + sh[c][i];
            u32x2 o; o[0] = pk2(u[0], u[1]); o[1] = pk2(u[2], u[3]);
            *(u32x2*)&U[(size_t)row * 1024 + c * 256 + lane * 4] = o;
#pragma unroll
            for (int h = 0; h < 8; ++h) {
                const f32x4 wv = *(const f32x4*)&sWf[h * 1024 + c * 256 + lane * 4];
                part[h] += u[0] * wv[0] + u[1] * wv[1] + u[2] * wv[2] + u[3] * wv[3];
            }
        }
        float f;
        {
            float q4[4], q2[2];
#pragma unroll
            for (int i = 0; i < 4; ++i) { const float keep = (lane & 1) ? part[2 * i + 1] : part[2 * i], give = (lane & 1) ? part[2 * i] : part[2 * i + 1]; q4[i] = keep + __shfl_xor(give, 1, 64); }
#pragma unroll
            for (int i = 0; i < 2; ++i) { const float keep = (lane & 2) ? q4[2 * i + 1] : q4[2 * i], give = (lane & 2) ? q4[2 * i] : q4[2 * i + 1]; q2[i] = keep + __shfl_xor(give, 2, 64); }
            { const float keep = (lane & 4) ? q2[1] : q2[0], give = (lane & 4) ? q2[0] : q2[1]; f = keep + __shfl_xor(give, 4, 64); }
            f += __shfl_xor(f, 8, 64); f += __shfl_xor(f, 16, 64); f += __shfl_xor(f, 32, 64);
        }
        if (lane < 8) {
            const float z = f + P.b_f[lane];
            const float lf = fminf(z, 0.f) - log1pf(expf(-fabsf(z)));
            logf[(size_t)(b * 8 + lane) * 2048 + (row & 2047)] = lf;
        }
    }
}

DI void pb_cumsum(const Params& P, int seq, float* smem) {
    const int tid = VTID;
    const float* lf = (const float*)(P.ws + OFF_LOGF) + (size_t)seq * 2048;
    float* cf = (float*)(P.ws + OFF_CUMF) + (size_t)seq * 2048;
    __syncthreads();
    f32x4 a = *(const f32x4*)&lf[tid * 8], b4 = *(const f32x4*)&lf[tid * 8 + 4];
    float v[8] = {a[0], a[1], a[2], a[3], b4[0], b4[1], b4[2], b4[3]};
#pragma unroll
    for (int i = 1; i < 8; ++i) v[i] += v[i - 1];
    smem[tid] = v[7];
    __syncthreads();
    if (tid == 0) { float run = 0.f; for (int i = 0; i < 256; ++i) { const float t = smem[i]; smem[i] = run; run += t; } }
    __syncthreads();
    const float off = smem[tid];
    f32x4 o0 = {v[0] + off, v[1] + off, v[2] + off, v[3] + off}, o1 = {v[4] + off, v[5] + off, v[6] + off, v[7] + off};
    *(f32x4*)&cf[tid * 8] = o0; *(f32x4*)&cf[tid * 8 + 4] = o1;
}

using f32x4v = __attribute__((ext_vector_type(4))) float;
DI void pc_s5a2(const Params& P, int g, int b, unsigned char* lds) {
    constexpr int LDA = 1032;
    const int tid = threadIdx.x, lane = tid & 63, w = tid >> 6, fr = lane & 15, fq = lane >> 4;
    u16* sA = (u16*)lds;
    float* sH = (float*)(lds + 32 * LDA * 2);
    const u16* A = (const u16*)(P.ws + OFF_XS) + ((size_t)(g * 256 + b * 32)) * 1024;
    const u16* bp = (const u16*)(P.ws + OFF_WST) + ((size_t)g * 128 + w * 16 + fr) * 1024 + fq * 8;
    u32x4 ar[8];
#pragma unroll
    for (int i = 0; i < 8; ++i) { const int id = tid + 512 * i; ar[i] = ldg16(A + (size_t)(id >> 7) * 1024 + (id & 127) * 8); }
    bf16x8 bfr[32];
#pragma unroll
    for (int ks = 0; ks < 32; ++ks) bfr[ks] = *(const bf16x8*)(bp + ks * 32);
    __syncthreads();
#pragma unroll
    for (int i = 0; i < 8; ++i) { const int id = tid + 512 * i; *(u32x4*)&sA[(id >> 7) * LDA + (id & 127) * 8] = ar[i]; }
    __syncthreads();
    f32x4v acc0 = {0.f, 0.f, 0.f, 0.f}, acc1 = {0.f, 0.f, 0.f, 0.f};
#pragma unroll
    for (int ks = 0; ks < 32; ++ks) {
        const bf16x8 a0 = *(const bf16x8*)&sA[fr * LDA + ks * 32 + fq * 8], a1 = *(const bf16x8*)&sA[(16 + fr) * LDA + ks * 32 + fq * 8];
        acc0 = __builtin_amdgcn_mfma_f32_16x16x32_bf16(a0, bfr[ks], acc0, 0, 0, 0);
        acc1 = __builtin_amdgcn_mfma_f32_16x16x32_bf16(a1, bfr[ks], acc1, 0, 0, 0);
    }
#pragma unroll
    for (int j = 0; j < 4; ++j) {
        sH[(fq * 4 + j) * 132 + w * 16 + fr] = acc0[j];
        sH[(16 + fq * 4 + j) * 132 + w * 16 + fr] = acc1[j];
    }
    __syncthreads();
    if (tid < 64) {
        const int p = tid;
        const f32x2_t al = ((const f32x2_t*)(P.ws + OFF_APL))[g * 64 + p];
        u16* HIN = (u16*)(P.ws + OFF_HIN);
        float hr = 0.f, hi = 0.f;
        for (int c = 0; c < 32; ++c) {
            *(unsigned*)&HIN[(size_t)(g * 256 + b * 32 + c) * 128 + 2 * p] = pk2(hr, hi);
            const float er = sH[c * 132 + 2 * p], ei = sH[c * 132 + 2 * p + 1];
            const float nr = al[0] * hr - al[1] * hi + er, ni2 = al[0] * hi + al[1] * hr + ei;
            hr = nr; hi = ni2;
        }
    }
}

constexpr int ATT_BUF = 64 * LDT * 2 * 2 + 256;
struct AttStage { u32x4 k, v; float nb; };
DI void att_load(AttStage& r, const u16* Kb, const u16* Vb, const float* CF, int t, int tid) {
    const int row = tid >> 3, c = tid & 7;
    r.k = ldg16(Kb + (size_t)(t * 64 + row) * 512 + c * 8);
    r.v = ldg16(Vb + (size_t)row * 16384 + t * 64 + c * 8);
    r.nb = CF[t * 64 + (tid & 63)];
}
constexpr int LDV = 68;
DI void att_store(const AttStage& r, unsigned char* buf, int tid) {
    const int row = tid >> 3, c = tid & 7;
    *(u32x4*)(buf + (row * LDT + c * 8) * 2) = r.k;
    u32x2 v0 = {r.v[0], r.v[1]}, v1 = {r.v[2], r.v[3]};
    *(u32x2*)(buf + 64 * LDT * 2 + (row * LDV + c * 8) * 2) = v0;
    *(u32x2*)(buf + 64 * LDT * 2 + (row * LDV + c * 8 + 4) * 2) = v1;
    if (tid < 64) *(float*)(buf + 64 * LDT * 4 + tid * 4) = -r.nb * LOG2E;
}
DI void att_s(f32x16 (&s)[2], const unsigned char* buf, int l31, int hf, const bf16x8 (&qf)[4]) {
    const u16* sK = (const u16*)buf;
    const float* sNb = (const float*)(buf + 64 * LDT * 4);
    bf16x8 kf[2][4];
#pragma unroll
    for (int kb = 0; kb < 2; ++kb)
#pragma unroll
        for (int ds = 0; ds < 4; ++ds) kf[kb][ds] = *(const bf16x8*)&sK[(kb * 32 + l31) * LDT + ds * 16 + hf * 8];
#pragma unroll
    for (int kb = 0; kb < 2; ++kb)
#pragma unroll
        for (int q = 0; q < 4; ++q) {
            const f32x4 nb = *(const f32x4*)&sNb[kb * 32 + 8 * q + 4 * hf];
            s[kb][4 * q] = nb[0]; s[kb][4 * q + 1] = nb[1]; s[kb][4 * q + 2] = nb[2]; s[kb][4 * q + 3] = nb[3];
        }
#pragma unroll
    for (int ds = 0; ds < 4; ++ds)
#pragma unroll
        for (int kb = 0; kb < 2; ++kb) s[kb] = MFMA(kf[kb][ds], qf[ds], s[kb]);
}
DI void att_pv(f32x16 (&s)[2], const unsigned char* buf, int k0, int qbase, int qrow, int l31, int hf, f32x16 (&o)[2], float& m, float& lsum) {
    const u16* sV = (const u16*)(buf + 64 * LDT * 2);
    if (__builtin_amdgcn_readfirstlane((int)(k0 + 63 > qbase))) {
#pragma unroll
        for (int kb = 0; kb < 2; ++kb)
#pragma unroll
            for (int i = 0; i < 16; ++i) { const int key = k0 + kb * 32 + (i & 3) + 8 * (i >> 2) + 4 * hf; s[kb][i] = (key > qrow) ? -INFINITY : s[kb][i]; }
    }
    float mloc = s[0][0];
    asm("v_max3_f32 %0, %0, %1, %2" : "+v"(mloc) : "v"(s[1][0]), "v"(s[0][1]));
#pragma unroll
    for (int i = 1; i < 15; ++i) asm("v_max3_f32 %0, %0, %1, %2" : "+v"(mloc) : "v"(s[1][i]), "v"(s[0][i + 1]));
    asm("v_max_f32 %0, %0, %1" : "+v"(mloc) : "v"(s[1][15]));
    mloc = fmaxf(mloc, __shfl_xor(mloc, 32, 64));
    const float mnew = fmaxf(m, mloc);
    const float alpha = __builtin_amdgcn_exp2f(m - mnew);
    m = mnew;
    float ps = 0.f;
#pragma unroll
    for (int kb = 0; kb < 2; ++kb)
#pragma unroll
        for (int i = 0; i < 16; ++i) { const float p = __builtin_amdgcn_exp2f(s[kb][i] - mnew); s[kb][i] = p; ps += p; }
    lsum = lsum * alpha + ps;
#pragma unroll
    for (int i = 0; i < 16; ++i) { o[0][i] *= alpha; o[1][i] *= alpha; }
#pragma unroll
    for (int kb = 0; kb < 2; ++kb)
#pragma unroll
        for (int st = 0; st < 2; ++st) {
            u32x4 pw;
            pw[0] = pk2(s[kb][8 * st + 0], s[kb][8 * st + 1]); pw[1] = pk2(s[kb][8 * st + 2], s[kb][8 * st + 3]);
            pw[2] = pk2(s[kb][8 * st + 4], s[kb][8 * st + 5]); pw[3] = pk2(s[kb][8 * st + 6], s[kb][8 * st + 7]);
            const bf16x8 pf = __builtin_bit_cast(bf16x8, pw);
#pragma unroll
            for (int db = 0; db < 2; ++db) {
                const u16* vp = &sV[(db * 32 + l31) * LDV + kb * 32 + 16 * st + 4 * hf];
                const u32x2 v0 = *(const u32x2*)vp, v1 = *(const u32x2*)(vp + 8);
                u32x4 vw = {v0[0], v0[1], v1[0], v1[1]};
                o[db] = MFMA(__builtin_bit_cast(bf16x8, vw), pf, o[db]);
            }
        }
}
DI void pc_attn3(const Params& P, int b, int h, int qblk, unsigned char* lds) {
    const int tid = threadIdx.x, lane = tid & 63, w = tid >> 6, hf = lane >> 5, l31 = lane & 31;
    const u16* Q = (const u16*)(P.ws + OFF_Q);
    const u16* ZA = (const u16*)(P.ws + OFF_ZA);
    const float* CF = (const float*)(P.ws + OFF_CUMF) + (size_t)(b * 8 + h) * 2048;
    const u16* Kb = (const u16*)(P.ws + OFF_K) + ((size_t)b * 2048) * 512 + h * 64;
    const u16* Vb = (const u16*)(P.ws + OFF_VT) + (size_t)(h * 64) * 16384 + (size_t)b * 2048;
    const int qbase = qblk * 256 + w * 32, qrow = qbase + l31;
    const size_t tokq = (size_t)b * 2048 + qrow;
    bf16x8 qf[4];
#pragma unroll
    for (int ds = 0; ds < 4; ++ds) qf[ds] = *(const bf16x8*)&Q[tokq * 512 + h * 64 + ds * 16 + hf * 8];
    f32x16 o[2], sa[2], sb[2];
#pragma unroll
    for (int i = 0; i < 16; ++i) { o[0][i] = 0.f; o[1][i] = 0.f; }
    float m = -INFINITY, lsum = 0.f;
    const int nkt = 4 * (qblk + 1);
    const int tlast = (qbase + 31) >> 6;
    AttStage r0, r1;
    att_load(r0, Kb, Vb, CF, 0, tid);
    att_load(r1, Kb, Vb, CF, 1, tid);
    __syncthreads();
    att_store(r0, lds, tid);
    att_store(r1, lds + ATT_BUF, tid);
    att_load(r0, Kb, Vb, CF, 2, tid);
    att_load(r1, Kb, Vb, CF, 3, tid);
    __syncthreads();
    att_s(sa, lds, l31, hf, qf);
    int b0 = 0, b1 = 1, b2 = 2;
    for (int t = 0; t < nkt; t += 2) {
        __syncthreads();
        if (t + 2 < nkt) { att_store(r0, lds + b2 * ATT_BUF, tid); if (t + 4 < nkt) att_load(r0, Kb, Vb, CF, t + 4, tid); }
        if (t + 1 <= tlast) att_s(sb, lds + b1 * ATT_BUF, l31, hf, qf);
        __builtin_amdgcn_sched_barrier(0);
        if (t <= tlast) att_pv(sa, lds + b0 * ATT_BUF, t * 64, qbase, qrow, l31, hf, o, m, lsum);
        __syncthreads();
        if (t + 3 < nkt) { att_store(r1, lds + b0 * ATT_BUF, tid); if (t + 5 < nkt) att_load(r1, Kb, Vb, CF, t + 5, tid); }
        if (t + 2 < nkt && t + 2 <= tlast) att_s(sa, lds + b2 * ATT_BUF, l31, hf, qf);
        __builtin_amdgcn_sched_barrier(0);
        if (t + 1 <= tlast) att_pv(sb, lds + b1 * ATT_BUF, (t + 1) * 64, qbase, qrow, l31, hf, o, m, lsum);
        { const int nb0 = b2, nb1 = b0, nb2 = b1; b0 = nb0; b1 = nb1; b2 = nb2; }
    }
    lsum += __shfl_xor(lsum, 32, 64);
    const float inv = 1.f / lsum;
    u16* AATT = (u16*)(P.ws + OFF_AB);
#pragma unroll
    for (int db = 0; db < 2; ++db)
#pragma unroll
        for (int q = 0; q < 4; ++q) {
            const int d = db * 32 + 8 * q + 4 * hf;
            const u32x2 zw = *(const u32x2*)&ZA[tokq * 512 + h * 64 + d];
            u32x2 ow;
            ow[0] = pk2(o[db][4 * q] * inv * bflo(zw[0]), o[db][4 * q + 1] * inv * bfhi(zw[0]));
            ow[1] = pk2(o[db][4 * q + 2] * inv * bflo(zw[1]), o[db][4 * q + 3] * inv * bfhi(zw[1]));
            *(u32x2*)&AATT[tokq * 1024 + 512 + h * 64 + d] = ow;
        }
}

DI float gelu_tanh(float y) {
    const float u = 0.7978845608028654f * (y + 0.044715f * y * y * y);
    const float e = __expf(2.f * u);
    const float th = 1.f - 2.f / (e + 1.f);
    return 0.5f * y * (1.f + th);
}
DI void pd_s5b(const Params& P, int g, int mt, int nt, u16* smem) {
    const u16* XS = (const u16*)(P.ws + OFF_XS);
    const u16* KU = (const u16*)(P.ws + OFF_KUNIQ) + (size_t)g * 64 * 256;
    const u16* WCT = (const u16*)(P.ws + OFF_WCT) + ((size_t)g * 1024 + nt * 128) * 128;
    const u16* HIN = (const u16*)(P.ws + OFF_HIN) + ((size_t)g * 256 + mt * 128) * 128;
    const int nkT = 2 * nt + 2;
    const int m0 = mt * 128;
    f32x16 acc[2][2];
    zero_acc<2>(acc);
    gemm_mainloop<2>(acc, nkT + 2,
        [=](int r, int ks, int c) {
            if (ks < nkT) return ldg16(XS + ((size_t)(g * 256 + m0 + r)) * 1024 + ks * 64 + c * 8);
            return ldg16(HIN + (size_t)r * 128 + (ks - nkT) * 64 + c * 8); },
        [=](int r, int ks, int c) {
            if (ks < nkT) { const int ng = nt * 128 + r, t = ng >> 4, ho = ng & 15, s = ks * 4 + (c >> 1), lag = t - s;
                            return ldg16(KU + ((lag < 0 ? 0 : lag) * 16 + ho) * 16 + (c & 1) * 8); }
            return ldg16(WCT + (size_t)r * 128 + (ks - nkT) * 64 + c * 8); },
        smem, smem + 128 * LDT,
        [=](int r, int ks, int c, u32x4 v) { const int t = (nt * 128 + r) >> 4, s = ks * 4 + (c >> 1); return (ks < nkT && s > t) ? zero4() : v; });
    u16* YS = (u16*)(P.ws + OFF_K);
    const int lane = VTID & 63, w = VTID >> 6, wr = w >> 1, wc = w & 1, hf = lane >> 5;
#pragma unroll
    for (int mi = 0; mi < 2; ++mi)
#pragma unroll
        for (int ni = 0; ni < 2; ++ni) {
            const int ng = nt * 128 + wc * 64 + ni * 32 + (lane & 31), t = ng >> 4, ho = ng & 15;
#pragma unroll
            for (int i = 0; i < 16; ++i) {
                const int m = m0 + wr * 64 + mi * 32 + (i & 3) + 8 * (i >> 2) + 4 * hf;
                const size_t tok = (size_t)(m >> 5) * 2048 + (m & 31) * 64 + t;
                YS[tok * 512 + g * 16 + ho] = f2bf(gelu_tanh(acc[mi][ni][i]));
            }
        }
}

DI void ph_ln(const Params& P, int row) {
    const int lane = tidx() & 63;
    float* o = P.out + (size_t)row * 1024;
    f32x4 xv[4];
#pragma unroll
    for (int c = 0; c < 4; ++c) xv[c] = *(const f32x4*)&o[c * 256 + lane * 4];
    float s = 0.f;
#pragma unroll
    for (int c = 0; c < 4; ++c) s += (xv[c][0] + xv[c][1]) + (xv[c][2] + xv[c][3]);
    const float mu = wave_sum(s) * (1.f / 1024.f);
    float v = 0.f;
#pragma unroll
    for (int c = 0; c < 4; ++c)
#pragma unroll
        for (int i = 0; i < 4; ++i) { const float d = xv[c][i] - mu; v += d * d; }
    const float rstd = 1.f / sqrtf(wave_sum(v) * (1.f / 1024.f) + LN_EPS);
#pragma unroll
    for (int c = 0; c < 4; ++c) {
        const f32x4 g = *(const f32x4*)&P.ln_g[c * 256 + lane * 4], bb = *(const f32x4*)&P.ln_b[c * 256 + lane * 4];
        f32x4 r;
#pragma unroll
        for (int i = 0; i < 4; ++i) r[i] = (xv[c][i] - mu) * rstd * g[i] + bb[i];
        *(f32x4*)&o[c * 256 + lane * 4] = r;
    }
}

namespace pg8 {
#define PG8_LAS __attribute__((address_space(3)))
typedef unsigned short bf16_t;
typedef short bf16x8 __attribute__((ext_vector_type(8)));
typedef float f32x4 __attribute__((ext_vector_type(4)));
typedef unsigned u32x4 __attribute__((ext_vector_type(4)));
constexpr int BM = 256, BK = 64, HALF = 128, HTB = HALF * BK * 2  , STAGE_BYTES = 8 * HTB, NXCD = 8, WGM = 8;

__host__ __device__ __forceinline__ int lds_byte(int r, int c) { const int st = (r >> 4) * 2 + (c >> 5), rr = r & 15, cc = c & 31, ob = rr * 64 + cc * 2; return st * 1024 + (ob ^ (((ob >> 9) & 1) << 5)); }
__host__ __device__ __forceinline__ void stage_rc(int b, int& R, int& C) { const int st = b / 1024, sb = b % 1024, swz = sb ^ (((sb >> 9) & 1) << 5); R = (st >> 1) * 16 + swz / 64; C = (st & 1) * 32 + (swz % 64) / 2; }
__host__ __device__ __forceinline__ int perm32(int rho) { const int n = rho >> 4, i = rho & 15; return 8 * (i >> 2) + 4 * n + (i & 3); }

struct Unit { int pm, pn; };
struct Gemm { const bf16_t* A; const bf16_t* Bt; int M, N, K; };

struct StaticOrder {
    int nM, nN, nwg, G, c;
    __host__ __device__ void init(int M, int N, int G_, int c_) { nM = M / BM; nN = N / BM; nwg = nM * nN; G = G_; c = c_; }
    __host__ __device__ bool next(int i, Unit& u) const {
        const long L = (long)i * G + c; if (L >= nwg) return false;
        int wgid = (int)L; { const int q = nwg / NXCD, r = nwg % NXCD, xcd = wgid % NXCD, off = wgid / NXCD; wgid = (xcd < r ? xcd * (q + 1) : r * (q + 1) + (xcd - r) * q) + off; }
        const int nig = WGM * nN, gid = wgid / nig, fm = gid * WGM, gsz = (nM - fm) < WGM ? (nM - fm) : WGM;
        u.pm = fm + ((wgid % nig) % gsz); u.pn = (wgid % nig) / gsz; return true;
    }
    __device__ __forceinline__ void a_ready(const Unit&) const {}
    __device__ __forceinline__ void done(const Unit&) const {}
};
template <class Epi, class Sched, bool STAMP = false>
__device__ __forceinline__ void gemm_phase(PG8_LAS unsigned char* lds, const Gemm g, const Sched& S, const Epi& E, unsigned long long* stamps) {
    const int tid = threadIdx.x, wid = __builtin_amdgcn_readfirstlane(tid >> 6), lane = tid & 63, wr = wid >> 2, wc = wid & 3, fr = lane & 15, fq = lane >> 4;
    const int K = g.K, nt = K / BK;
    int ts_lo = 0, ts_hi = 0, nts = 0; const unsigned long long rt_entry = STAMP ? (unsigned long long)wall_clock64() : 0ull;
#define PG8_STAMP() do { if (STAMP && wid == 0 && nts < 64) { const unsigned long long _c = (unsigned long long)clock64(); \
        ts_lo = (lane == nts) ? (int)(unsigned)_c : ts_lo; ts_hi = (lane == nts) ? (int)(unsigned)(_c >> 32) : ts_hi; ++nts; } } while (0)
    PG8_STAMP();
    unsigned voffA[2], voffB[2];
#pragma unroll
    for (int i = 0; i < 2; ++i) { int R, C; stage_rc(tid * 16 + i * 8192, R, C); const int Rb = Epi::PERM ? ((R & ~31) + perm32(R & 31)) : R;
        voffA[i] = (unsigned)(R * K + C) * 2u; voffB[i] = (unsigned)(Rb * K + C) * 2u; }
    const size_t kstep = (size_t)(BK * 2);
    const size_t hstep = (size_t)HALF * K * 2;
    const size_t tstep = 2 * hstep;
    const unsigned ldsw = (unsigned)wid * 1024u;
    const int aoff = lds_byte(wr * 64 + fr, fq * 8), boff = lds_byte(wc * 32 + fr, fq * 8);
#define PG8_SA(b, h) (((b) * 2 + (h)) * HTB)
#define PG8_SB(b, h) ((4 + (b) * 2 + (h)) * HTB)
#define PG8_STAGE(bufoff, gbase, voff) do { _Pragma("unroll") for (int _i = 0; _i < 2; ++_i) \
        __builtin_amdgcn_global_load_lds((const unsigned*)((const char*)(gbase) + (voff)[_i]), (PG8_LAS unsigned*)(lds + (bufoff) + ldsw + _i * 8192), 16, 0, 0); } while (0)
#define PG8_LDA(dst, b, h) do { _Pragma("unroll") for (int m = 0; m < 4; ++m) _Pragma("unroll") for (int k = 0; k < 2; ++k) dst[m][k] = *(const PG8_LAS bf16x8*)(lds + PG8_SA(b, h) + aoff + m * 2048 + k * 1024); } while (0)
#define PG8_LDB(dst, b, h) do { _Pragma("unroll") for (int n = 0; n < 2; ++n) _Pragma("unroll") for (int k = 0; k < 2; ++k) dst[n][k] = *(const PG8_LAS bf16x8*)(lds + PG8_SB(b, h) + boff + n * 2048 + k * 1024); } while (0)
#define PG8_MMA(ai, bj, At, Bt) do { __builtin_amdgcn_s_setprio(1); _Pragma("unroll") for (int m = 0; m < 4; ++m) _Pragma("unroll") for (int n = 0; n < 2; ++n) _Pragma("unroll") for (int k = 0; k < 2; ++k) \
        acc[ai][bj][m][n] = __builtin_amdgcn_mfma_f32_16x16x32_bf16(Bt[n][k], At[m][k], acc[ai][bj][m][n], 0, 0, 0); __builtin_amdgcn_s_setprio(0); } while (0)
#define PG8_WAIT_V(n) asm volatile("s_waitcnt vmcnt(" #n ")" ::: "memory")
#define PG8_WAIT_L(n) asm volatile("s_waitcnt lgkmcnt(" #n ")" ::: "memory")
#define PG8_BAR __builtin_amdgcn_s_barrier()
#define PG8_SCHED __builtin_amdgcn_sched_barrier(0)
    Unit cur, nxt; int ui = 0;
    if (!S.next(0, cur)) return;
    f32x4 acc[2][2][4][2];
#pragma unroll
    for (int a = 0; a < 2; ++a)
#pragma unroll
        for (int b = 0; b < 2; ++b)
#pragma unroll
            for (int m = 0; m < 4; ++m)
#pragma unroll
                for (int n = 0; n < 2; ++n) acc[a][b][m][n] = (f32x4){0.f, 0.f, 0.f, 0.f};
    bf16x8 At[4][2], B0[2][2], B1[2][2];
    const char* cA = (const char*)g.A + (size_t)cur.pm * tstep; const char* cB = (const char*)g.Bt + (size_t)cur.pn * tstep;
    S.a_ready(cur);
    PG8_STAGE(PG8_SB(0, 0), cB, voffB); PG8_STAGE(PG8_SA(0, 0), cA, voffA); PG8_STAGE(PG8_SB(0, 1), cB + hstep, voffB); PG8_STAGE(PG8_SA(0, 1), cA + hstep, voffA);
    if (wr == 1) PG8_BAR;
    PG8_WAIT_V(4); PG8_BAR;
    PG8_STAGE(PG8_SB(1, 0), cB + kstep, voffB); PG8_STAGE(PG8_SA(1, 0), cA + kstep, voffA); PG8_STAGE(PG8_SB(1, 1), cB + hstep + kstep, voffB);
    PG8_WAIT_V(6); PG8_BAR;
    PG8_STAMP();
    for (;;) {
        const bool has_next = S.next(ui + 1, nxt);
        const char* nA = has_next ? (const char*)g.A + (size_t)nxt.pm * tstep : cA; const char* nB = has_next ? (const char*)g.Bt + (size_t)nxt.pn * tstep : cB;
        for (int t = 0; t < nt; t += 2) {
            const bool last = (t == nt - 2);
            if constexpr (Epi::MID) { if (t == (nt >> 1)) E.mid(acc, cur, wr, wc, fr, fq); }
            const char* a1 = cA + (size_t)(t + 1) * kstep;
            const char* a2 = last ? nA : cA + (size_t)(t + 2) * kstep; const char* b2 = last ? nB : cB + (size_t)(t + 2) * kstep;
            const char* a3 = a2 + kstep; const char* b3 = b2 + kstep;
            if (last && has_next) S.a_ready(nxt);
            PG8_LDB(B0, 0, 0); PG8_SCHED; PG8_LDA(At, 0, 0); PG8_STAGE(PG8_SA(1, 1), a1 + hstep, voffA);
            PG8_WAIT_L(8); PG8_BAR; PG8_WAIT_L(0); PG8_MMA(0, 0, At, B0); PG8_BAR; PG8_SCHED;
            PG8_LDB(B1, 0, 1); PG8_STAGE(PG8_SB(0, 0), b2, voffB);
            PG8_BAR; PG8_WAIT_L(0); PG8_MMA(0, 1, At, B1); PG8_BAR;
            PG8_LDA(At, 0, 1); PG8_STAGE(PG8_SA(0, 0), a2, voffA);
            PG8_BAR; PG8_WAIT_L(0); PG8_MMA(1, 0, At, B0); PG8_BAR; PG8_SCHED;
            PG8_STAGE(PG8_SB(0, 1), b2 + hstep, voffB);
            PG8_WAIT_V(6); PG8_BAR; PG8_MMA(1, 1, At, B1); PG8_BAR;
            PG8_LDB(B0, 1, 0); PG8_SCHED; PG8_LDA(At, 1, 0); PG8_STAGE(PG8_SA(0, 1), a2 + hstep, voffA);
            PG8_WAIT_L(8); PG8_BAR; PG8_WAIT_L(0); PG8_MMA(0, 0, At, B0); PG8_BAR; PG8_SCHED;
            PG8_LDB(B1, 1, 1); PG8_STAGE(PG8_SB(1, 0), b3, voffB);
            PG8_BAR; PG8_WAIT_L(0); PG8_MMA(0, 1, At, B1); PG8_BAR;
            PG8_LDA(At, 1, 1); PG8_STAGE(PG8_SA(1, 0), a3, voffA);
            PG8_BAR; PG8_WAIT_L(0); PG8_MMA(1, 0, At, B0); PG8_BAR; PG8_SCHED;
            PG8_STAGE(PG8_SB(1, 1), b3 + hstep, voffB);
            PG8_WAIT_V(6); PG8_BAR; PG8_MMA(1, 1, At, B1); PG8_BAR;
        }
        PG8_STAMP();
        if constexpr (!Epi::AFTER_DRAIN) { E(acc, cur, wr, wc, fr, fq); S.done(cur); }
        PG8_STAMP();
        if (!has_next) break;
#pragma unroll
        for (int a = 0; a < 2; ++a)
#pragma unroll
            for (int b = 0; b < 2; ++b)
#pragma unroll
                for (int m = 0; m < 4; ++m)
#pragma unroll
                    for (int n = 0; n < 2; ++n) acc[a][b][m][n] = (f32x4){0.f, 0.f, 0.f, 0.f};
        cur = nxt; cA = nA; cB = nB; ++ui;
    }
    PG8_WAIT_V(0);
    if (wr == 0) PG8_BAR;
    PG8_BAR;
    if constexpr (Epi::AFTER_DRAIN) { E.fused(acc, cur, wr, wc, fr, fq, lds, wid, lane); S.done(cur); }
    PG8_STAMP();
    if (STAMP && wid == 0) { stamps[lane] = lane < nts ? (((unsigned long long)(unsigned)ts_hi << 32) | (unsigned)ts_lo) : 0ull;
        if (lane == 62) stamps[62] = rt_entry; if (lane == 63) stamps[63] = (unsigned long long)wall_clock64(); }
#undef PG8_STAMP
#undef PG8_SA
#undef PG8_SB
#undef PG8_STAGE
#undef PG8_LDA
#undef PG8_LDB
#undef PG8_MMA
#undef PG8_WAIT_V
#undef PG8_WAIT_L
#undef PG8_BAR
#undef PG8_SCHED
}
}

typedef pg8::f32x4 pf4;
struct EpiProj {
    static constexpr bool PERM = true, AFTER_DRAIN = false, MID = false;
    unsigned char* ws;
    DI void operator()(const pf4 (&acc)[2][2][4][2], const pg8::Unit& u, int wr, int wc, int fr, int fq) const {
        const int pn = u.pn; u16* base; int ld, cb, act;
        if (pn < 10) { const int seg = pn >> 1; base = (u16*)(ws + (seg == 0 ? OFF_XS : seg == 1 ? OFF_ZS : seg == 2 ? OFF_Q : seg == 3 ? OFF_K : OFF_ZA)); ld = 512; cb = (pn & 1) * 256; act = (seg == 1 || seg == 4) ? 1 : 0; }
        else if (pn < 14) { base = (u16*)(ws + OFF_GS); ld = 1024; cb = (pn - 10) * 256; act = 2; }
        else { base = (u16*)(ws + OFF_GA); ld = 1024; cb = (pn - 14) * 256; act = 2; }
        const int row0 = u.pm * 256 + wr * 64 + fr, col0 = cb + wc * 32 + 8 * fq;
        if (pn < 2) {
#pragma unroll
            for (int ai = 0; ai < 2; ++ai)
#pragma unroll
                for (int m = 0; m < 4; ++m) {
                    const int r = row0 + ai * 128 + m * 16, bc = r >> 6, sl = r & 63;
#pragma unroll
                    for (int bj = 0; bj < 2; ++bj) {
                        const int ch = col0 + bj * 128, g = ch >> 4, hi0 = ch & 15;
                        const pf4 a = acc[ai][bj][m][0], b4 = acc[ai][bj][m][1];
                        u32x4 w = {pk2(a[0], a[1]), pk2(a[2], a[3]), pk2(b4[0], b4[1]), pk2(b4[2], b4[3])};
                        *(u32x4*)(base + ((size_t)(g * 256 + bc)) * 1024 + sl * 16 + hi0) = w;
                    }
                }
            return;
        }
        if (pn == 4 || pn == 5) act = 3;
#pragma unroll
        for (int ai = 0; ai < 2; ++ai)
#pragma unroll
            for (int m = 0; m < 4; ++m) {
                u16* rowp = base + (size_t)(row0 + ai * 128 + m * 16) * ld + col0;
#pragma unroll
                for (int bj = 0; bj < 2; ++bj) {
                    float v[8];
#pragma unroll
                    for (int j = 0; j < 4; ++j) { v[j] = acc[ai][bj][m][0][j]; v[4 + j] = acc[ai][bj][m][1][j]; }
                    if (act == 3) {
#pragma unroll
                        for (int j = 0; j < 8; ++j) v[j] *= (0.125f * LOG2E);
                    } else if (act == 1) {
#pragma unroll
                        for (int j = 0; j < 8; ++j) v[j] = siluf_(v[j]);
                    } else if (act == 2) {
#pragma unroll
                        for (int j = 0; j < 8; ++j) v[j] = sigmoidf_(v[j]);
                    }
                    u32x4 w = {pk2(v[0], v[1]), pk2(v[2], v[3]), pk2(v[4], v[5]), pk2(v[6], v[7])};
                    *(u32x4*)(rowp + bj * 128) = w;
                }
            }
    }
};
struct EpiPlain {
    static constexpr bool PERM = true, AFTER_DRAIN = false, MID = false;
    u16* C; int ld;
    DI void operator()(const pf4 (&acc)[2][2][4][2], const pg8::Unit& u, int wr, int wc, int fr, int fq) const {
        const int row0 = u.pm * 256 + wr * 64 + fr, col0 = u.pn * 256 + wc * 32 + 8 * fq;
#pragma unroll
        for (int ai = 0; ai < 2; ++ai)
#pragma unroll
            for (int m = 0; m < 4; ++m) {
                u16* rowp = C + (size_t)(row0 + ai * 128 + m * 16) * ld + col0;
#pragma unroll
                for (int bj = 0; bj < 2; ++bj) {
                    const pf4 a = acc[ai][bj][m][0], b = acc[ai][bj][m][1];
                    u32x4 w = {pk2(a[0], a[1]), pk2(a[2], a[3]), pk2(b[0], b[1]), pk2(b[2], b[3])};
                    *(u32x4*)(rowp + bj * 128) = w;
                }
            }
    }
};
struct EpiGlu {
    static constexpr bool PERM = true, AFTER_DRAIN = false, MID = false;
    const u16* ZS; u16* AS;
    DI void operator()(const pf4 (&acc)[2][2][4][2], const pg8::Unit& u, int wr, int wc, int fr, int fq) const {
        const int row0 = u.pm * 256 + wr * 64 + fr, ch0 = u.pn * 128 + wc * 32 + 8 * fq;
#pragma unroll
        for (int ai = 0; ai < 2; ++ai)
#pragma unroll
            for (int m = 0; m < 4; ++m) {
                const size_t off = (size_t)(row0 + ai * 128 + m * 16) * 512 + ch0;
                const size_t offo = (size_t)(row0 + ai * 128 + m * 16) * 1024 + ch0;
                const u32x4 z = *(const u32x4*)(ZS + off);
                float o[8];
#pragma unroll
                for (int j = 0; j < 4; ++j) {
                    o[j] = acc[ai][0][m][0][j] * sigmoidf_(acc[ai][1][m][0][j]);
                    o[4 + j] = acc[ai][0][m][1][j] * sigmoidf_(acc[ai][1][m][1][j]);
                }
                u32x4 w = {pk2(o[0] * bflo(z[0]), o[1] * bfhi(z[0])), pk2(o[2] * bflo(z[1]), o[3] * bfhi(z[1])),
                           pk2(o[4] * bflo(z[2]), o[5] * bfhi(z[2])), pk2(o[6] * bflo(z[3]), o[7] * bfhi(z[3]))};
                *(u32x4*)(AS + offo) = w;
            }
    }
};
struct EpiMerge {
    static constexpr bool PERM = true, AFTER_DRAIN = false, MID = true;
    const u16* GS; const u16* GA; u16* MG;
    DI void mid(pf4 (&acc)[2][2][4][2], const pg8::Unit& u, int, int, int, int) const {
        const int t_ = tidx(), wid = t_ >> 6, lane = t_ & 63, wr = wid >> 2, wc = wid & 3, fr = lane & 15, fq = lane >> 4;
        const int row0 = u.pm * 256 + wr * 64 + fr, col0 = u.pn * 256 + wc * 32 + 8 * fq;
#pragma unroll
        for (int ai = 0; ai < 2; ++ai)
#pragma unroll
            for (int m = 0; m < 4; ++m) {
#pragma unroll
                for (int bj = 0; bj < 2; ++bj) {
                    const size_t off = (size_t)(row0 + ai * 128 + m * 16) * 1024 + col0 + bj * 128;
                    const u32x4 s4 = *(const u32x4*)(GS + off), a4 = *(const u32x4*)(GA + off);
#pragma unroll
                    for (int j = 0; j < 4; ++j) {
                        const float sl = bflo(s4[j]), sh = bfhi(s4[j]), al = fmaxf(bflo(a4[j]), 1e-30f), ah = fmaxf(bfhi(a4[j]), 1e-30f);
                        acc[ai][bj][m][j >> 1][(j & 1) * 2] *= sl * __builtin_amdgcn_rcpf(al);
                        acc[ai][bj][m][j >> 1][(j & 1) * 2 + 1] *= sh * __builtin_amdgcn_rcpf(ah);
                    }
                }
                asm volatile("" ::: "memory");
            }
    }
    DI void operator()(const pf4 (&acc)[2][2][4][2], const pg8::Unit& u, int wr, int wc, int fr, int fq) const {
        const int row0 = u.pm * 256 + wr * 64 + fr, col0 = u.pn * 256 + wc * 32 + 8 * fq;
#pragma unroll
        for (int ai = 0; ai < 2; ++ai)
#pragma unroll
            for (int m = 0; m < 4; ++m)
#pragma unroll
                for (int bj = 0; bj < 2; ++bj) {
                    const size_t off = (size_t)(row0 + ai * 128 + m * 16) * 1024 + col0 + bj * 128;
                    const u32x4 a4 = *(const u32x4*)(GA + off);
                    const pf4 x = acc[ai][bj][m][0], y = acc[ai][bj][m][1];
                    u32x4 w = {pk2(x[0] * bflo(a4[0]), x[1] * bfhi(a4[0])), pk2(x[2] * bflo(a4[1]), x[3] * bfhi(a4[1])),
                               pk2(y[0] * bflo(a4[2]), y[1] * bfhi(a4[2])), pk2(y[2] * bflo(a4[3]), y[3] * bfhi(a4[3]))};
                    *(u32x4*)(MG + off) = w;
                }
    }
};
struct EpiOut {
    static constexpr bool PERM = false, AFTER_DRAIN = false, MID = false;
    const float* X; const float* MOD; float* O;
    DI void operator()(const pf4 (&acc)[2][2][4][2], const pg8::Unit& u, int wr, int wc, int fr, int fq) const {
        const int row0 = u.pm * 256 + wr * 64 + fr, col0 = u.pn * 256 + wc * 32 + 4 * fq;
        const float* gate = MOD + (u.pm >> 3) * 3072 + 2048;
#pragma unroll
        for (int bj = 0; bj < 2; ++bj)
#pragma unroll
            for (int n = 0; n < 2; ++n) {
                const pf4 gt = *(const pf4*)(gate + col0 + bj * 128 + n * 16);
#pragma unroll
                for (int ai = 0; ai < 2; ++ai)
#pragma unroll
                    for (int m = 0; m < 4; ++m) {
                        const size_t off = (size_t)(row0 + ai * 128 + m * 16) * 1024 + col0 + bj * 128 + n * 16;
                        const pf4 x = *(const pf4*)(X + off);
                        const pf4 a = acc[ai][bj][m][n];
                        pf4 o = {DN_ALPHA * x[0] + a[0] * gt[0], DN_ALPHA * x[1] + a[1] * gt[1], DN_ALPHA * x[2] + a[2] * gt[2], DN_ALPHA * x[3] + a[3] * gt[3]};
                        *(pf4*)(O + off) = o;
                    }
            }
    }
};

constexpr int VB_LDS = 49152;
constexpr int LDS_BYTES = 131072 + 64;
__global__ void __launch_bounds__(512, 2) fwd_megakernel(Params P) {
    extern __shared__ __attribute__((aligned(16))) unsigned char lds_raw[];
    const int tid = threadIdx.x, bid = blockIdx.x, nb = gridDim.x;
    const int nv = nb * 2;
#define VB (tidx() >> 8)
    volatile unsigned* st = (volatile unsigned*)(lds_raw + 131072);
    if (tid < 4) st[tid] = 0u;
    __syncthreads();
    XcdBarrier bar; bar.bar = (unsigned*)(P.ws + OFF_BAR); bar.x = xb_xcc_id(); bar.st = st;
    if (tid == 0) (void)xb_add(&bar.bar[XB_XCNT(bar.x)], 1u);
    PG8_LAS unsigned char* stage = (PG8_LAS unsigned char*)lds_raw;
    unsigned char* ws = P.ws;

    {
        const int vb = VB, v = bid * 2 + vb;
        float* sa = (float*)(lds_raw + 32768 + vb * VB_LDS);
        for (int it = v; it < 768 + 96; it += nv) {
            if (it < 768) { const int part = it % 3, gj = it / 3; pa_s5(P, gj >> 3, gj & 7, part, sa); }
            else pa_mod(P, it - 768, sa);
        }
    }
    xcd_barrier(bar);
    {
        const int vb = VB, v = bid * 2 + vb;
        float* sWf = (float*)lds_raw;
        u16* sa = (u16*)(lds_raw + 32768 + vb * VB_LDS);
        for (int i = tidx(); i < 8192; i += 512) { const int k = i >> 3, h = i & 7; sWf[h * 1024 + k] = P.w_in[(size_t)k * INCOLS + 2560 + h]; }
        __syncthreads();
        for (int it = v; it < 512 + 1920; it += nv) {
            if (it < 512) { pa2_rows(P, it, sWf); continue; }
            int t = it - 512;
            if (t < 1280) pa_transpose(P.w_in, INCOLS, 1024, (u16*)(ws + OFF_WINT), 0, t / 80, t % 80, sa);
            else if ((t -= 1280) < 128) pa_transpose(P.w_glu, 1024, 512, (u16*)(ws + OFF_WGLUT), 1, t >> 4, t & 15, sa);
            else if ((t -= 128) < 128) pa_transpose(P.w_ps, 1024, 1024, (u16*)(ws + OFF_WPST), 2, t >> 4, t & 15, sa);
            else if ((t -= 128) < 128) pa_transpose(P.w_pa, 1024, 1024, (u16*)(ws + OFF_WPST) + 512, 2, t >> 4, t & 15, sa);
            else { t -= 128; pa_transpose(P.w_out, 1024, 1024, (u16*)(ws + OFF_WOUTT), 2, t >> 4, t & 15, sa); }
        }
    }
    xcd_barrier(bar);
    { const int vb = VB, v = bid * 2 + vb; for (int it = v; it < 64; it += nv) pb_cumsum(P, it, (float*)(lds_raw + vb * VB_LDS)); }
    __syncthreads();
    {
        pg8::Gemm g; g.A = (const u16*)(ws + OFF_U); g.Bt = (const u16*)(ws + OFF_WINT); g.M = NTOK; g.N = 4608; g.K = 1024;
        pg8::StaticOrder S; S.init(g.M, g.N, nb, bid);
        EpiProj E; E.ws = ws;
        pg8::gemm_phase<EpiProj, pg8::StaticOrder, false>(stage, g, S, E, nullptr);
    }
    {
        pg8::Gemm g; g.A = (const u16*)(ws + OFF_WINT) + (size_t)4608 * 1024; g.Bt = (const u16*)(ws + OFF_U); g.M = 512; g.N = NTOK; g.K = 1024;
        pg8::StaticOrder S; S.init(g.M, g.N, nb, (bid + 128) % nb);
        EpiPlain E; E.C = (u16*)(ws + OFF_VT); E.ld = NTOK;
        pg8::gemm_phase<EpiPlain, pg8::StaticOrder, false>(stage, g, S, E, nullptr);
    }
    xcd_barrier(bar);
    __syncthreads();
    for (int it = bid; it < 256; it += nb) pc_s5a2(P, it >> 3, it & 7, lds_raw);
    {
        for (int it = bid; it < 256; it += nb) {
            const int xi = it >> 3, bh = (it & 7) * 8 + (xi >> 2), j = xi & 3;
            pc_attn3(P, bh >> 3, bh & 7, 7 - j, lds_raw);
            pc_attn3(P, bh >> 3, bh & 7, j, lds_raw);
        }
    }
    xcd_barrier(bar);
    { const int vb = VB, v = bid * 2 + vb; u16* smem = (u16*)(lds_raw + vb * VB_LDS); for (int it = v; it < 512; it += nv) { const int nt = 7 - (it >> 6), r = it & 63; pd_s5b(P, r >> 1, r & 1, nt, smem); } }
    xcd_barrier(bar);
    {
        pg8::Gemm g; g.A = (const u16*)(ws + OFF_K); g.Bt = (const u16*)(ws + OFF_WGLUT); g.M = NTOK; g.N = 1024; g.K = 512;
        pg8::StaticOrder S; S.init(g.M, g.N, nb, bid);
        EpiGlu E; E.ZS = (const u16*)(ws + OFF_ZS); E.AS = (u16*)(ws + OFF_AB);
        pg8::gemm_phase<EpiGlu, pg8::StaticOrder, false>(stage, g, S, E, nullptr);
    }
    xcd_barrier(bar);
    {
        pg8::Gemm g; g.A = (const u16*)(ws + OFF_AB); g.Bt = (const u16*)(ws + OFF_WPST); g.M = NTOK; g.N = 1024; g.K = 1024;
        pg8::StaticOrder S; S.init(g.M, g.N, nb, bid);
        EpiMerge E; E.GS = (const u16*)(ws + OFF_GS); E.GA = (const u16*)(ws + OFF_GA); E.MG = (u16*)(ws + OFF_MG);
        pg8::gemm_phase<EpiMerge, pg8::StaticOrder, false>(stage, g, S, E, nullptr);
    }
    xcd_barrier(bar);
    {
        pg8::Gemm g; g.A = (const u16*)(ws + OFF_MG); g.Bt = (const u16*)(ws + OFF_WOUTT); g.M = NTOK; g.N = 1024; g.K = 1024;
        pg8::StaticOrder S; S.init(g.M, g.N, nb, bid);
        EpiOut E; E.X = P.x; E.MOD = (const float*)(ws + OFF_MOD); E.O = P.out;
        pg8::gemm_phase<EpiOut, pg8::StaticOrder, false>(stage, g, S, E, nullptr);
    }
    xcd_barrier(bar);
    for (int row = bid * 8 + (tidx() >> 6); row < NTOK; row += nb * 8) ph_ln(P, row);
}

extern "C" void kernel_launch(void* const* d_in, const int* in_sizes, int n_in, void* d_out, int out_size, void* d_ws, size_t ws_size, hipStream_t stream) {
    static int grid = 0;
    if (grid == 0) {
        if (ws_size < WS_END) { fprintf(stderr, "kernel_launch: workspace too small: %zu < %zu\n", ws_size, (size_t)WS_END); grid = -1; return; }
        int dev = 0, cus = 0, per_cu = 0;
        (void)hipGetDevice(&dev);
        (void)hipDeviceGetAttribute(&cus, hipDeviceAttributeMultiprocessorCount, dev);
        if (hipFuncSetAttribute((const void*)fwd_megakernel, hipFuncAttributeMaxDynamicSharedMemorySize, LDS_BYTES) != hipSuccess) { fprintf(stderr, "kernel_launch: hipFuncSetAttribute failed\n"); grid = -1; return; }
        (void)hipOccupancyMaxActiveBlocksPerMultiprocessor(&per_cu, (const void*)fwd_megakernel, 512, LDS_BYTES);
        if (per_cu < 1) { fprintf(stderr, "kernel_launch: occupancy query returned %d\n", per_cu); grid = -1; return; }
        grid = cus;
        if (grid != 256) fprintf(stderr, "kernel_launch: note: %d CUs (GEMM units are balanced for 256)\n", grid);
    }
    if (grid < 0) return;
    (void)hipMemsetAsync((char*)d_ws + OFF_BAR, 0, 16384, stream);
    Params p{};
    const float** pp = (const float**)&p;
    for (int i = 0; i < 20; ++i) pp[i] = (const float*)d_in[i];
    p.out = (float*)d_out; p.ws = (unsigned char*)d_ws;
    void* args[] = {&p};
    hipError_t e = hipLaunchCooperativeKernel((const void*)fwd_megakernel, dim3(grid), dim3(512), args, LDS_BYTES, stream);
    if (e != hipSuccess) fprintf(stderr, "cooperative launch failed: %s (grid %d)\n", hipGetErrorString(e), grid);
}
```
